# Optimizing an MI355X kernel written in HIP

```python
import jax, jax.numpy as jnp
from jax import lax
import numpy as np

D_MODEL = 1024
BATCH = 4
SEQ = 8192
DEPTH = 1

POOL_WINDOWS = (2, 4, 8, 16)
POOL_GROUPS = len(POOL_WINDOWS)
POOL_GROUP_DIM = D_MODEL // 16
POOL_WIDTH = POOL_GROUPS * POOL_GROUP_DIM
ATTN_PATTERNS = ((128, 1), (512, 4), (2048, 16))
N_ATTN_GROUPS = len(ATTN_PATTERNS)
HEAD_DIM = 64
HEADS_PER_GROUP = 4
N_ATTN_HEADS = N_ATTN_GROUPS * HEADS_PER_GROUP
ATTN_WIDTH = N_ATTN_HEADS * HEAD_DIM
ATTN_OUT_WIDTH = HEADS_PER_GROUP * HEAD_DIM
ROPE_THETA = 10000.0
BLOCK = 128
N_BRANCHES = 2
IN_WIDTH = POOL_WIDTH + 3 * ATTN_WIDTH + N_BRANCHES * D_MODEL
D_FF = ((8 * D_MODEL // 3 + 255) // 256) * 256
N_MOD = 9
EPS = 1e-6

kernel_name = "hybrid_pool_dilated_attn_macaron_block"


def rmsnorm(x, g):
    xf = x.astype(jnp.float32)
    y = xf * lax.rsqrt(jnp.mean(xf * xf, axis=-1, keepdims=True) + EPS)
    return (y * g.astype(jnp.float32)).astype(x.dtype)


def modulate(x, shift, scale):
    return x * (1 + scale) + shift


def swiglu(u, w_in, w_out):
    a, b = jnp.split(u @ w_in, 2, axis=-1)
    return (jax.nn.silu(a) * b) @ w_out


def rope_tables(positions, dtype):
    inv_freq = ROPE_THETA ** (-jnp.arange(0, HEAD_DIM, 2, dtype=jnp.float32) / HEAD_DIM)
    ang = positions.astype(jnp.float32)[..., None] * inv_freq
    return jnp.cos(ang)[:, :, None, :].astype(dtype), jnp.sin(ang)[:, :, None, :].astype(dtype)


def apply_rope(t, cos, sin):
    t1, t2 = jnp.split(t, 2, axis=-1)
    return jnp.concatenate([t1 * cos - t2 * sin, t2 * cos + t1 * sin], axis=-1)


def multiscale_pool(p, w_pool, pool_scale):
    B, S, _ = p.shape
    pf = p.astype(jnp.float32)
    cs = jnp.pad(jnp.cumsum(pf, axis=1), ((0, 0), (1, 0), (0, 0)))
    t = jnp.arange(S)
    outs = []
    for gi, w in enumerate(POOL_WINDOWS):
        sl = slice(gi * POOL_GROUP_DIM, (gi + 1) * POOL_GROUP_DIM)
        csg = cs[..., sl]
        lagged = jnp.pad(csg[:, :S + 1 - w], ((0, 0), (w - 1, 0), (0, 0)))
        count = jnp.minimum(t + 1, w).astype(jnp.float32)[None, :, None]
        outs.append((csg[:, 1:] - lagged) / count - pf[..., sl])
    d = jnp.stack(outs, axis=2).astype(p.dtype)
    y = jnp.einsum('bsgc,gcd->bsgd', d, w_pool)
    return y.reshape(B, S, POOL_WIDTH) * pool_scale


def dilated_window_attention(q, k, v, steps, dilation):
    B, S, H, Dh = q.shape
    L = S // dilation
    nb = -(-L // BLOCK)
    Lp = nb * BLOCK

    def to_strided(t):
        t = t.reshape(B, L, dilation, H, Dh).transpose(0, 3, 2, 1, 4)
        return jnp.pad(t, ((0, 0), (0, 0), (0, 0), (0, Lp - L), (0, 0)))

    qs, ks, vs = to_strided(q), to_strided(k), to_strided(v)
    qb = qs.reshape(B, H, dilation, nb, BLOCK, Dh)

    def band(t):
        tp = jnp.pad(t, ((0, 0), (0, 0), (0, 0), (BLOCK, 0), (0, 0)))
        prev = tp[..., :Lp, :].reshape(B, H, dilation, nb, BLOCK, Dh)
        cur = t.reshape(B, H, dilation, nb, BLOCK, Dh)
        return jnp.concatenate([prev, cur], axis=-2)

    kb, vb = band(ks), band(vs)
    a = jnp.arange(BLOCK)[:, None]
    cidx = jnp.arange(2 * BLOCK)[None, :]
    rel = a + BLOCK - cidx
    in_band = (rel >= 0) & (rel <= steps)
    key_pos = jnp.arange(nb)[:, None, None] * BLOCK - BLOCK + cidx[None]
    mask = in_band[None] & (key_pos >= 0)

    s = jnp.einsum('bhrnqd,bhrnkd->bhrnqk', qb, kb).astype(jnp.float32) * (HEAD_DIM ** -0.5)
    s = jnp.where(mask, s, -jnp.inf)
    lse = jax.nn.logsumexp(s, axis=-1)
    pr = jnp.exp(s - lse[..., None]).astype(v.dtype)
    o = jnp.einsum('bhrnqk,bhrnkd->bhrnqd', pr, vb)
    o = o.reshape(B, H, dilation, Lp, Dh)[:, :, :, :L]
    o = o.transpose(0, 3, 2, 1, 4).reshape(B, S, H, Dh)
    lse = lse.reshape(B, H, dilation, Lp)[:, :, :, :L].transpose(0, 3, 2, 1).reshape(B, S, H)
    return o, lse


def token_mixing(u, cos, sin, w_in, w_pool, pool_scale, w_pool_branch, w_attn_branch, w_out):
    B, S, _ = u.shape
    proj = u @ w_in
    cuts = [POOL_WIDTH, POOL_WIDTH + ATTN_WIDTH, POOL_WIDTH + 2 * ATTN_WIDTH,
            POOL_WIDTH + 3 * ATTN_WIDTH]
    p, q, k, v, gate_logits = jnp.split(proj, cuts, axis=-1)

    y_pool = multiscale_pool(p, w_pool, pool_scale)

    q = apply_rope(q.reshape(B, S, N_ATTN_HEADS, HEAD_DIM), cos, sin)
    k = apply_rope(k.reshape(B, S, N_ATTN_HEADS, HEAD_DIM), cos, sin)
    v = v.reshape(B, S, N_ATTN_HEADS, HEAD_DIM)
    outs, lses = [], []
    for gi, (window, dilation) in enumerate(ATTN_PATTERNS):
        hs = slice(gi * HEADS_PER_GROUP, (gi + 1) * HEADS_PER_GROUP)
        o, lse = dilated_window_attention(q[:, :, hs], k[:, :, hs], v[:, :, hs],
                                          window // dilation, dilation)
        outs.append(o)
        lses.append(lse)
    wts = jax.nn.softmax(jnp.stack(lses, axis=0), axis=0)
    y_attn = jnp.einsum('gbsh,gbshd->bshd', wts.astype(v.dtype), jnp.stack(outs, axis=0))
    y_attn = y_attn.reshape(B, S, ATTN_OUT_WIDTH)

    gates = jax.nn.sigmoid(gate_logits.astype(jnp.float32)).astype(u.dtype)
    g_pool, g_attn = jnp.split(gates, N_BRANCHES, axis=-1)
    merged = g_pool * (y_pool @ w_pool_branch) + g_attn * (y_attn @ w_attn_branch)
    return merged @ w_out


def setup_inputs(seed: int = 0) -> dict:
    key = jax.random.key(seed)
    ks = jax.random.split(key, 20)
    f32 = jnp.float32

    def lin(k, shape, fan_in, scale=1.0):
        return jax.random.normal(k, shape, f32) * (scale * fan_in ** -0.5)

    def gain(k, shape):
        return 1.0 + 0.05 * jax.random.normal(k, shape, f32)

    x = jax.random.normal(ks[0], (BATCH, SEQ, D_MODEL), f32)
    c = jax.random.normal(ks[1], (BATCH, D_MODEL), f32)
    offset = jax.random.randint(ks[2], (BATCH, 1), 0, 1024, dtype=jnp.int32)
    positions = (jnp.arange(SEQ, dtype=jnp.int32)[None, :] + offset).astype(jnp.int32)
    return {
        "x": x,
        "c": c,
        "positions": positions,
        "w_ada": lin(ks[3], (DEPTH, D_MODEL, N_MOD * D_MODEL), D_MODEL, 0.5),
        "b_ada": 0.02 * jax.random.normal(ks[4], (DEPTH, N_MOD * D_MODEL), f32),
        "g_norm_ffn1": gain(ks[5], (DEPTH, D_MODEL)),
        "w_ffn1_in": lin(ks[6], (DEPTH, D_MODEL, 2 * D_FF), D_MODEL),
        "w_ffn1_out": lin(ks[7], (DEPTH, D_FF, D_MODEL), D_FF),
        "g_norm_mix": gain(ks[8], (DEPTH, D_MODEL)),
        "w_in": lin(ks[9], (DEPTH, D_MODEL, IN_WIDTH), D_MODEL),
        "w_pool": lin(ks[10], (DEPTH, POOL_GROUPS, POOL_GROUP_DIM, POOL_GROUP_DIM), POOL_GROUP_DIM),
        "pool_scale": 1.0 + 0.1 * jax.random.normal(ks[11], (DEPTH, POOL_WIDTH), f32),
        "w_pool_branch": lin(ks[12], (DEPTH, POOL_WIDTH, D_MODEL), POOL_WIDTH),
        "w_attn_branch": lin(ks[13], (DEPTH, ATTN_OUT_WIDTH, D_MODEL), ATTN_OUT_WIDTH),
        "w_out": lin(ks[14], (DEPTH, D_MODEL, D_MODEL), D_MODEL),
        "g_norm_ffn2": gain(ks[15], (DEPTH, D_MODEL)),
        "w_ffn2_in": lin(ks[16], (DEPTH, D_MODEL, 2 * D_FF), D_MODEL),
        "w_ffn2_out": lin(ks[17], (DEPTH, D_FF, D_MODEL), D_FF),
        "g_final": gain(ks[18], (D_MODEL,)),
    }


def reference(x, c, positions, w_ada, b_ada, g_norm_ffn1, w_ffn1_in, w_ffn1_out,
              g_norm_mix, w_in, w_pool, pool_scale, w_pool_branch, w_attn_branch, w_out,
              g_norm_ffn2, w_ffn2_in, w_ffn2_out, g_final):
    cos, sin = rope_tables(positions, x.dtype)
    cond = jax.nn.silu(c)
    h = x
    for l in range(DEPTH):
        mod = cond @ w_ada[l] + b_ada[l]
        sh1, sc1, gt1, sh2, sc2, gt2, sh3, sc3, gt3 = [
            m[:, None, :] for m in jnp.split(mod, N_MOD, axis=-1)]
        u = modulate(rmsnorm(h, g_norm_ffn1[l]), sh1, sc1)
        h = h + 0.5 * gt1 * swiglu(u, w_ffn1_in[l], w_ffn1_out[l])
        u = modulate(rmsnorm(h, g_norm_mix[l]), sh2, sc2)
        h = h + gt2 * token_mixing(u, cos, sin, w_in[l], w_pool[l], pool_scale[l],
                                   w_pool_branch[l], w_attn_branch[l], w_out[l])
        u = modulate(rmsnorm(h, g_norm_ffn2[l]), sh3, sc3)
        h = h + 0.5 * gt3 * swiglu(u, w_ffn2_in[l], w_ffn2_out[l])
    return rmsnorm(h, g_final)
```

```cpp
#include <hip/hip_runtime.h>
#include <cstdio>
#include <cstdint>
#define MK_N_LAUNCHES 1
namespace pg8 {
#define PG8_LAS __attribute__((address_space(3)))
typedef unsigned short bf16_t;
typedef short bf16x8 __attribute__((ext_vector_type(8)));
typedef float f32x4 __attribute__((ext_vector_type(4)));
typedef unsigned u32x4 __attribute__((ext_vector_type(4)));
constexpr int BM = 256, BK = 64, HALF = 128, HTB = HALF * BK * 2  , STAGE_BYTES = 8 * HTB, NXCD = 8, WGM = 8;

__host__ __device__ __forceinline__ int lds_byte(int r, int c) { const int st = (r >> 4) * 2 + (c >> 5), rr = r & 15, cc = c & 31, ob = rr * 64 + cc * 2; return st * 1024 + (ob ^ (((ob >> 9) & 1) << 5)); }
__host__ __device__ __forceinline__ void stage_rc(int b, int& R, int& C) { const int st = b / 1024, sb = b % 1024, swz = sb ^ (((sb >> 9) & 1) << 5); R = (st >> 1) * 16 + swz / 64; C = (st & 1) * 32 + (swz % 64) / 2; }
__host__ __device__ __forceinline__ int perm32(int rho) { const int n = rho >> 4, i = rho & 15; return 8 * (i >> 2) + 4 * n + (i & 3); }

struct Unit { int pm, pn; };
struct Gemm { const bf16_t* A; const bf16_t* Bt; int M, N, K; };

struct StaticOrder {
    int nM, nN, nwg, G, c;
    __host__ __device__ void init(int M, int N, int G_, int c_) { nM = M / BM; nN = N / BM; nwg = nM * nN; G = G_; c = c_; }
    __host__ __device__ bool next(int i, Unit& u) const {
        const long L = (long)i * G + c; if (L >= nwg) return false;
        int wgid = (int)L; { const int q = nwg / NXCD, r = nwg % NXCD, xcd = wgid % NXCD, off = wgid / NXCD; wgid = (xcd < r ? xcd * (q + 1) : r * (q + 1) + (xcd - r) * q) + off; }
        const int nig = WGM * nN, gid = wgid / nig, fm = gid * WGM, gsz = (nM - fm) < WGM ? (nM - fm) : WGM;
        u.pm = fm + ((wgid % nig) % gsz); u.pn = (wgid % nig) / gsz; return true;
    }
    __device__ __forceinline__ void a_ready(const Unit&) const {}
    __device__ __forceinline__ void done(const Unit&) const {}
};

__device__ __forceinline__ unsigned cvt_pk_bf16(float lo, float hi) { unsigned r; asm volatile("v_cvt_pk_bf16_f32 %0, %1, %2" : "=v"(r) : "v"(lo), "v"(hi)); return r; }
template <class Epi, class Sched, bool ALIGN_EPI = false, bool SP2 = false>
__device__ __forceinline__ void gemm_phase(PG8_LAS unsigned char* lds, const Gemm g, const Sched& S, const Epi& E) {
    const int tid = threadIdx.x, wid = __builtin_amdgcn_readfirstlane(tid >> 6), lane = tid & 63, wr = wid >> 2, wc = wid & 3, fr = lane & 15, fq = lane >> 4;
    const int K = g.K, nt = K / BK;
    unsigned voffA[2], voffB[2];
#pragma unroll
    for (int i = 0; i < 2; ++i) { int R, C; stage_rc(tid * 16 + i * 8192, R, C); const int Rb = Epi::PERM ? ((R & ~31) + perm32(R & 31)) : R;
        voffA[i] = (unsigned)(R * K + C) * 2u; voffB[i] = (unsigned)(Rb * K + C) * 2u; }
    const size_t kstep = (size_t)(BK * 2);
    const size_t hstep = (size_t)HALF * K * 2;
    const size_t tstep = 2 * hstep;
    const unsigned ldsw = (unsigned)wid * 1024u;
    const int aoff = lds_byte(wr * 64 + fr, fq * 8), boff = lds_byte(wc * 32 + fr, fq * 8);
#define PG8_SA(b, h) (((b) * 2 + (h)) * HTB)
#define PG8_SB(b, h) ((4 + (b) * 2 + (h)) * HTB)
#define PG8_STAGE(bufoff, gbase, voff) do { _Pragma("unroll") for (int _i = 0; _i < 2; ++_i) \
        __builtin_amdgcn_global_load_lds((const unsigned*)((const char*)(gbase) + (voff)[_i]), (PG8_LAS unsigned*)(lds + (bufoff) + ldsw + _i * 8192), 16, 0, 0); } while (0)
#define PG8_LDA(dst, b, h) do { _Pragma("unroll") for (int m = 0; m < 4; ++m) _Pragma("unroll") for (int k = 0; k < 2; ++k) dst[m][k] = *(const PG8_LAS bf16x8*)(lds + PG8_SA(b, h) + aoff + m * 2048 + k * 1024); } while (0)
#define PG8_LDB(dst, b, h) do { _Pragma("unroll") for (int n = 0; n < 2; ++n) _Pragma("unroll") for (int k = 0; k < 2; ++k) dst[n][k] = *(const PG8_LAS bf16x8*)(lds + PG8_SB(b, h) + boff + n * 2048 + k * 1024); } while (0)
#define PG8_MMA(ai, bj, At, Bt) do { __builtin_amdgcn_s_setprio(1); _Pragma("unroll") for (int m = 0; m < 4; ++m) _Pragma("unroll") for (int n = 0; n < 2; ++n) _Pragma("unroll") for (int k = 0; k < 2; ++k) \
        acc[ai][bj][m][n] = __builtin_amdgcn_mfma_f32_16x16x32_bf16(Bt[n][k], At[m][k], acc[ai][bj][m][n], 0, 0, 0); __builtin_amdgcn_s_setprio(0); } while (0)
#define PG8_WAIT_V(n) asm volatile("s_waitcnt vmcnt(" #n ")" ::: "memory")
#define PG8_WAIT_L(n) asm volatile("s_waitcnt lgkmcnt(" #n ")" ::: "memory")
#define PG8_BAR __builtin_amdgcn_s_barrier()
#define PG8_SCHED __builtin_amdgcn_sched_barrier(0)
    Unit cur, nxt; int ui = 0;
    if (!S.next(0, cur)) return;
    f32x4 acc[2][2][4][2];
#pragma unroll
    for (int a = 0; a < 2; ++a)
#pragma unroll
        for (int b = 0; b < 2; ++b)
#pragma unroll
            for (int m = 0; m < 4; ++m)
#pragma unroll
                for (int n = 0; n < 2; ++n) acc[a][b][m][n] = (f32x4){0.f, 0.f, 0.f, 0.f};
    bf16x8 At[4][2], B0[2][2], B1[2][2];
    const char* cA = (const char*)g.A + (size_t)cur.pm * tstep; const char* cB = (const char*)g.Bt + (size_t)cur.pn * tstep;
    S.a_ready(cur);
    if constexpr (SP2) {
        PG8_STAGE(PG8_SB(0, 0), cB, voffB); PG8_STAGE(PG8_SB(0, 1), cB + hstep, voffB); PG8_STAGE(PG8_SA(0, 0), cA, voffA); PG8_STAGE(PG8_SA(0, 1), cA + hstep, voffA);
        if (wr == 1) PG8_BAR;
        PG8_WAIT_V(2); PG8_BAR;
        PG8_STAGE(PG8_SB(1, 0), cB + kstep, voffB); PG8_STAGE(PG8_SA(1, 0), cA + kstep, voffA); PG8_STAGE(PG8_SB(1, 1), cB + hstep + kstep, voffB);
        PG8_WAIT_V(6); PG8_BAR;
    } else {
        PG8_STAGE(PG8_SB(0, 0), cB, voffB); PG8_STAGE(PG8_SA(0, 0), cA, voffA); PG8_STAGE(PG8_SB(0, 1), cB + hstep, voffB); PG8_STAGE(PG8_SA(0, 1), cA + hstep, voffA);
        if (wr == 1) PG8_BAR;
        PG8_WAIT_V(4); PG8_BAR;
        PG8_STAGE(PG8_SB(1, 0), cB + kstep, voffB); PG8_STAGE(PG8_SA(1, 0), cA + kstep, voffA); PG8_STAGE(PG8_SB(1, 1), cB + hstep + kstep, voffB);
        PG8_WAIT_V(6); PG8_BAR;
    }
    for (;;) {
        const bool has_next = S.next(ui + 1, nxt);
        const char* nA = has_next ? (const char*)g.A + (size_t)nxt.pm * tstep : cA; const char* nB = has_next ? (const char*)g.Bt + (size_t)nxt.pn * tstep : cB;
        for (int t = 0; t < nt; t += 2) {
            const bool last = (t == nt - 2);
            const char* a1 = cA + (size_t)(t + 1) * kstep;
            const char* a2 = last ? nA : cA + (size_t)(t + 2) * kstep; const char* b2 = last ? nB : cB + (size_t)(t + 2) * kstep;
            const char* a3 = a2 + kstep; const char* b3 = b2 + kstep;
            if (last && has_next) S.a_ready(nxt);
            if constexpr (SP2) {
            PG8_LDB(B0, 0, 0); PG8_LDB(B1, 0, 1); PG8_SCHED; PG8_LDA(At, 0, 0); PG8_STAGE(PG8_SA(1, 1), a1 + hstep, voffA);
            PG8_WAIT_V(8); PG8_WAIT_L(0); PG8_BAR; PG8_MMA(0, 0, At, B0); PG8_MMA(0, 1, At, B1); PG8_BAR; PG8_SCHED;
            PG8_LDA(At, 0, 1); PG8_STAGE(PG8_SB(0, 0), b2, voffB); PG8_STAGE(PG8_SB(0, 1), b2 + hstep, voffB); PG8_STAGE(PG8_SA(0, 0), a2, voffA);
            PG8_WAIT_V(8); PG8_WAIT_L(0); PG8_BAR; PG8_MMA(1, 0, At, B0); PG8_MMA(1, 1, At, B1); PG8_BAR; PG8_SCHED;
            PG8_LDB(B0, 1, 0); PG8_LDB(B1, 1, 1); PG8_SCHED; PG8_LDA(At, 1, 0); PG8_STAGE(PG8_SA(0, 1), a2 + hstep, voffA);
            PG8_WAIT_V(8); PG8_WAIT_L(0); PG8_BAR; PG8_MMA(0, 0, At, B0); PG8_MMA(0, 1, At, B1); PG8_BAR; PG8_SCHED;
            PG8_LDA(At, 1, 1); PG8_STAGE(PG8_SB(1, 0), b3, voffB); PG8_STAGE(PG8_SB(1, 1), b3 + hstep, voffB); PG8_STAGE(PG8_SA(1, 0), a3, voffA);
            PG8_WAIT_V(8); PG8_WAIT_L(0); PG8_BAR; PG8_MMA(1, 0, At, B0); PG8_MMA(1, 1, At, B1); PG8_BAR; PG8_SCHED;
            } else {
            PG8_LDB(B0, 0, 0); PG8_SCHED; PG8_LDA(At, 0, 0); PG8_STAGE(PG8_SA(1, 1), a1 + hstep, voffA);
            PG8_WAIT_L(8); PG8_BAR; PG8_WAIT_L(0); PG8_MMA(0, 0, At, B0); PG8_BAR; PG8_SCHED;
            PG8_LDB(B1, 0, 1); PG8_STAGE(PG8_SB(0, 0), b2, voffB);
            PG8_BAR; PG8_WAIT_L(0); PG8_MMA(0, 1, At, B1); PG8_BAR;
            PG8_LDA(At, 0, 1); PG8_STAGE(PG8_SA(0, 0), a2, voffA);
            PG8_BAR; PG8_WAIT_L(0); PG8_MMA(1, 0, At, B0); PG8_BAR; PG8_SCHED;
            PG8_STAGE(PG8_SB(0, 1), b2 + hstep, voffB);
            PG8_WAIT_V(6); PG8_BAR; PG8_MMA(1, 1, At, B1); PG8_BAR;
            PG8_LDB(B0, 1, 0); PG8_SCHED; PG8_LDA(At, 1, 0); PG8_STAGE(PG8_SA(0, 1), a2 + hstep, voffA);
            PG8_WAIT_L(8); PG8_BAR; PG8_WAIT_L(0); PG8_MMA(0, 0, At, B0); PG8_BAR; PG8_SCHED;
            PG8_LDB(B1, 1, 1); PG8_STAGE(PG8_SB(1, 0), b3, voffB);
            PG8_BAR; PG8_WAIT_L(0); PG8_MMA(0, 1, At, B1); PG8_BAR;
            PG8_LDA(At, 1, 1); PG8_STAGE(PG8_SA(1, 0), a3, voffA);
            PG8_BAR; PG8_WAIT_L(0); PG8_MMA(1, 0, At, B0); PG8_BAR; PG8_SCHED;
            PG8_STAGE(PG8_SB(1, 1), b3 + hstep, voffB);
            PG8_WAIT_V(6); PG8_BAR; PG8_MMA(1, 1, At, B1); PG8_BAR;
            }
        }
        if constexpr (ALIGN_EPI) { if (wr == 0) PG8_BAR; }
        if constexpr (!Epi::AFTER_DRAIN) { E(acc, cur, wr, wc, fr, fq); S.done(cur); }
        if (!has_next) break;
#pragma unroll
        for (int a = 0; a < 2; ++a)
#pragma unroll
            for (int b = 0; b < 2; ++b)
#pragma unroll
                for (int m = 0; m < 4; ++m)
#pragma unroll
                    for (int n = 0; n < 2; ++n) acc[a][b][m][n] = (f32x4){0.f, 0.f, 0.f, 0.f};
        cur = nxt; cA = nA; cB = nB; ++ui;
        if constexpr (ALIGN_EPI) { if (wr == 1) PG8_BAR; }
    }
    PG8_WAIT_V(0);
    if constexpr (!ALIGN_EPI) { if (wr == 0) PG8_BAR; }
    PG8_BAR;
    if constexpr (Epi::AFTER_DRAIN) { E.fused(acc, cur, wr, wc, fr, fq, lds, wid, lane); S.done(cur); }
#undef PG8_SA
#undef PG8_SB
#undef PG8_STAGE
#undef PG8_LDA
#undef PG8_LDB
#undef PG8_MMA
#undef PG8_WAIT_V
#undef PG8_WAIT_L
#undef PG8_BAR
#undef PG8_SCHED
}
}
namespace mk {
using pg8::f32x4; using pg8::u32x4; using pg8::bf16_t; using pg8::Unit;
typedef float f32x2_t __attribute__((ext_vector_type(2))); typedef __bf16 bf16x2_t __attribute__((ext_vector_type(2)));
__device__ __forceinline__ unsigned cvt_pk_bf16(float lo, float hi) { f32x2_t v = {lo, hi}; bf16x2_t b = __builtin_convertvector(v, bf16x2_t); return __builtin_bit_cast(unsigned, b); }
constexpr int NB = 4, SEQ = 8192, DM = 1024, M = NB * SEQ;
constexpr int DFF = 2816, NFF = 2 * DFF;
constexpr int NIN = 4608;
constexpr int NMOD = 9 * DM;
constexpr int QKVW = 768;
constexpr float EPS = 1e-6f;
constexpr float C2 = 0.125f * 1.4426950408889634f;
constexpr int TPB = SEQ / 256;

__device__ __forceinline__ u32x4 pack8(const f32x4 a, const f32x4 b) {
    u32x4 w; w.x = cvt_pk_bf16(a[0], a[1]); w.y = cvt_pk_bf16(a[2], a[3]); w.z = cvt_pk_bf16(b[0], b[1]); w.w = cvt_pk_bf16(b[2], b[3]); return w;
}
__device__ __forceinline__ float bf_lo(unsigned u) { return __uint_as_float(u << 16); }
__device__ __forceinline__ float bf_hi(unsigned u) { return __uint_as_float(u & 0xffff0000u); }
__device__ __forceinline__ float sigmoid_f(float a) { return __builtin_amdgcn_rcpf(1.0f + __builtin_amdgcn_exp2f(-1.4426950408889634f * a)); }
__device__ __forceinline__ f32x4 sigmoid4(const f32x4 a) { f32x4 r; r[0] = sigmoid_f(a[0]); r[1] = sigmoid_f(a[1]); r[2] = sigmoid_f(a[2]); r[3] = sigmoid_f(a[3]); return r; }
__device__ __forceinline__ float row_rstd(const float* ssq, int row, int fq) {
    const f32x4 v = *(const f32x4*)(ssq + (size_t)row * 16 + 4 * fq);
    float s = (v[0] + v[1]) + (v[2] + v[3]);
    s += __shfl_xor(s, 16); s += __shfl_xor(s, 32);
    return __builtin_amdgcn_rsqf(s * (1.0f / (float)DM) + EPS);
}


template <bool NORM> struct EpiSwiglu {
    static constexpr bool PERM = true, AFTER_DRAIN = false;
    bf16_t* H; const float* ssq; const float* bias;
    __device__ __forceinline__ void operator()(const f32x4 (&acc)[2][2][4][2], const Unit& u, int wr, int wc, int fr, int fq) const {
        const int row0 = u.pm * 256 + wr * 64 + fr, hcol = u.pn * 128 + wc * 32 + 8 * fq;
        f32x4 bv[2][2];
        if (NORM) { const float* bp = bias + (size_t)(u.pm / TPB) * NFF + u.pn * 256 + wc * 32 + 8 * fq;
#pragma unroll
            for (int bj = 0; bj < 2; ++bj)
#pragma unroll
                for (int n = 0; n < 2; ++n) bv[bj][n] = *(const f32x4*)(bp + bj * 128 + 4 * n); }
#pragma unroll
        for (int ai = 0; ai < 2; ++ai)
#pragma unroll
            for (int m = 0; m < 4; ++m) {
                const int row = row0 + ai * 128 + m * 16;
                f32x4 a0 = acc[ai][0][m][0], a1 = acc[ai][0][m][1], b0 = acc[ai][1][m][0], b1 = acc[ai][1][m][1];
                if (NORM) { const float rs = row_rstd(ssq, row, fq); a0 = a0 * rs + bv[0][0]; a1 = a1 * rs + bv[0][1]; b0 = b0 * rs + bv[1][0]; b1 = b1 * rs + bv[1][1]; }
                const f32x4 h0 = a0 * sigmoid4(a0) * b0, h1 = a1 * sigmoid4(a1) * b1;
                *(u32x4*)(H + (size_t)row * DFF + hcol) = pack8(h0, h1);
            }
    }
};

template <bool AOUT, bool HALFG> struct EpiResid {
    static constexpr bool PERM = true, AFTER_DRAIN = false;
    const float* hin; float* hout; const float* gate; bf16_t* A; const float* g; const float* sc; float* ssq;
    __device__ __forceinline__ void operator()(const f32x4 (&acc)[2][2][4][2], const Unit& u, int wr, int wc, int fr, int fq) const {
        const int b = u.pm / TPB, row0 = u.pm * 256 + wr * 64 + fr, col0 = u.pn * 256 + wc * 32 + 8 * fq;
        f32x4 gt[2][2], gs[2][2];
#pragma unroll
        for (int bj = 0; bj < 2; ++bj)
#pragma unroll
            for (int n = 0; n < 2; ++n) { const int c = col0 + bj * 128 + 4 * n;
                gt[bj][n] = *(const f32x4*)(gate + (size_t)b * NMOD + c) * (HALFG ? 0.5f : 1.0f);
                if (AOUT) gs[bj][n] = *(const f32x4*)(g + c) * (*(const f32x4*)(sc + (size_t)b * NMOD + c) + 1.0f); }
#pragma unroll
        for (int ai = 0; ai < 2; ++ai)
#pragma unroll
            for (int m = 0; m < 4; ++m) {
                const int row = row0 + ai * 128 + m * 16; const size_t off = (size_t)row * DM + col0;
                f32x4 hv[2][2]; float q = 0.f;
#pragma unroll
                for (int bj = 0; bj < 2; ++bj)
#pragma unroll
                    for (int n = 0; n < 2; ++n) { const f32x4 r = *(const f32x4*)(hin + off + bj * 128 + 4 * n); const f32x4 h = r + gt[bj][n] * acc[ai][bj][m][n]; hv[bj][n] = h;
                        *(f32x4*)(hout + off + bj * 128 + 4 * n) = h; q += (h[0] * h[0] + h[1] * h[1]) + (h[2] * h[2] + h[3] * h[3]); }
                if (AOUT) {
#pragma unroll
                    for (int bj = 0; bj < 2; ++bj) *(u32x4*)(A + off + bj * 128) = pack8(hv[bj][0] * gs[bj][0], hv[bj][1] * gs[bj][1]); }
                q += __shfl_xor(q, 16); q += __shfl_xor(q, 32);
                if (fq == 0) ssq[(size_t)row * 16 + 4 * u.pn + wc] = q;
                if (m & 1) asm volatile("" ::: "memory");
            }
    }
};

struct EpiInProj {
    static constexpr bool PERM = true, AFTER_DRAIN = false;
    const float* ssq; const float* bias; const float* cs; float* PP; bf16_t* Q; bf16_t* K; bf16_t* V; bf16_t* G;
    __device__ __forceinline__ void operator()(const f32x4 (&acc)[2][2][4][2], const Unit& u, int wr, int wc, int fr, int fq) const {
        const int row0 = u.pm * 256 + wr * 64 + fr, pn = u.pn;
        f32x4 bv[2][2];
        { const float* bp = bias + (size_t)(u.pm / TPB) * NIN + pn * 256 + wc * 32 + 8 * fq;
#pragma unroll
            for (int bj = 0; bj < 2; ++bj)
#pragma unroll
                for (int n = 0; n < 2; ++n) bv[bj][n] = *(const f32x4*)(bp + bj * 128 + 4 * n); }
        if (pn == 0) {
#pragma unroll
            for (int ai = 0; ai < 2; ++ai)
#pragma unroll
                for (int m = 0; m < 4; ++m) { const int row = row0 + ai * 128 + m * 16; const float rs = row_rstd(ssq, row, fq);
                    float* dst = PP + (size_t)row * 256 + wc * 32 + 8 * fq;
#pragma unroll
                    for (int bj = 0; bj < 2; ++bj)
#pragma unroll
                        for (int n = 0; n < 2; ++n) *(f32x4*)(dst + bj * 128 + 4 * n) = acc[ai][bj][m][n] * rs + bv[bj][n]; }
        } else if (pn <= 6) {
            const bool isq = pn <= 3; const int head = 4 * (isq ? pn - 1 : pn - 4) + wc; const float osc = isq ? C2 : 1.0f;
            bf16_t* base = (isq ? Q : K) + head * 64 + 8 * fq;
#pragma unroll
            for (int ai = 0; ai < 2; ++ai)
#pragma unroll
                for (int m = 0; m < 4; ++m) { const int row = row0 + ai * 128 + m * 16; const float rs = row_rstd(ssq, row, fq) ;
                    const float* cp = cs + (size_t)row * 64 + 8 * fq;
                    f32x4 o1[2], o2[2];
#pragma unroll
                    for (int n = 0; n < 2; ++n) { const f32x4 c = *(const f32x4*)(cp + 4 * n) * osc, s = *(const f32x4*)(cp + 32 + 4 * n) * osc;
                        const f32x4 x1 = acc[ai][0][m][n] * rs + bv[0][n], x2 = acc[ai][1][m][n] * rs + bv[1][n];
                        o1[n] = x1 * c - x2 * s; o2[n] = x2 * c + x1 * s; }
                    bf16_t* dst = base + (size_t)row * QKVW;
                    *(u32x4*)dst = pack8(o1[0], o1[1]); *(u32x4*)(dst + 32) = pack8(o2[0], o2[1]); }
        } else if (pn <= 9) {
            bf16_t* base = V + (pn - 7) * 256 + wc * 32 + 8 * fq;
#pragma unroll
            for (int ai = 0; ai < 2; ++ai)
#pragma unroll
                for (int m = 0; m < 4; ++m) { const int row = row0 + ai * 128 + m * 16; const float rs = row_rstd(ssq, row, fq);
                    bf16_t* dst = base + (size_t)row * QKVW;
#pragma unroll
                    for (int bj = 0; bj < 2; ++bj) *(u32x4*)(dst + bj * 128) = pack8(acc[ai][bj][m][0] * rs + bv[bj][0], acc[ai][bj][m][1] * rs + bv[bj][1]); }
        } else {
            bf16_t* base = G + (pn - 10) * 256 + wc * 32 + 8 * fq;
#pragma unroll
            for (int ai = 0; ai < 2; ++ai)
#pragma unroll
                for (int m = 0; m < 4; ++m) { const int row = row0 + ai * 128 + m * 16; const float rs = row_rstd(ssq, row, fq);
                    bf16_t* dst = base + (size_t)row * 2048;
#pragma unroll
                    for (int bj = 0; bj < 2; ++bj) *(u32x4*)(dst + bj * 128) = pack8(sigmoid4(acc[ai][bj][m][0] * rs + bv[bj][0]), sigmoid4(acc[ai][bj][m][1] * rs + bv[bj][1])); }
        }
    }
};

struct EpiMerge {
    static constexpr bool PERM = true, AFTER_DRAIN = false;
    const bf16_t* G; bf16_t* Y;
    __device__ __forceinline__ void operator()(const f32x4 (&acc)[2][2][4][2], const Unit& u, int wr, int wc, int fr, int fq) const {
        const int row0 = u.pm * 256 + wr * 64 + fr, c = u.pn * 128 + wc * 32 + 8 * fq;
#pragma unroll
        for (int ai = 0; ai < 2; ++ai)
#pragma unroll
            for (int m = 0; m < 4; ++m) { const int row = row0 + ai * 128 + m * 16;
                const u32x4 gp = *(const u32x4*)(G + (size_t)row * 2048 + c), ga = *(const u32x4*)(G + (size_t)row * 2048 + 1024 + c);
                const f32x4 p0 = {bf_lo(gp.x), bf_hi(gp.x), bf_lo(gp.y), bf_hi(gp.y)}, p1 = {bf_lo(gp.z), bf_hi(gp.z), bf_lo(gp.w), bf_hi(gp.w)};
                const f32x4 a0 = {bf_lo(ga.x), bf_hi(ga.x), bf_lo(ga.y), bf_hi(ga.y)}, a1 = {bf_lo(ga.z), bf_hi(ga.z), bf_lo(ga.w), bf_hi(ga.w)};
                const f32x4 y0 = p0 * acc[ai][0][m][0] + a0 * acc[ai][1][m][0], y1 = p1 * acc[ai][0][m][1] + a1 * acc[ai][1][m][1];
                *(u32x4*)(Y + (size_t)row * DM + c) = pack8(y0, y1); }
    }
};
}
constexpr int NWAVES = 8;
#ifdef MK_PROBE
constexpr int NPH = 14;
#else
constexpr int NPH = 11;
#endif
#ifndef MK_N_LAUNCHES
#define MK_N_LAUNCHES 1
#endif
constexpr int N_LAUNCHES = MK_N_LAUNCHES;
static_assert(N_LAUNCHES == 1 || N_LAUNCHES == NPH, "MK_N_LAUNCHES is 1 or NPH");

using mk::NB; using mk::SEQ; using mk::DM; using mk::M; using mk::DFF; using mk::NFF; using mk::NIN; using mk::NMOD; using mk::QKVW;

constexpr size_t MiB = 1u << 20;
constexpr size_t WS_CTL = 0, CTL_ZERO_BYTES = 1 * MiB;
constexpr size_t WS_MOD = 1 * MiB;
constexpr size_t WS_BIAS2 = 1 * MiB + 256 * 1024;
constexpr size_t WS_BIAS3 = 1 * MiB + 512 * 1024;
constexpr size_t WS_SSQ2 = 2 * MiB, WS_SSQ3 = 4 * MiB, WS_SSQF = 6 * MiB;
constexpr size_t WS_CS = 8 * MiB;
constexpr size_t WS_W1IN = 16 * MiB, WS_W1OUT = 27 * MiB, WS_WIN = 33 * MiB, WS_WM = 42 * MiB, WS_WOUT = 44 * MiB, WS_W2IN = 46 * MiB, WS_W2OUT = 57 * MiB;
constexpr size_t WS_XA = 64 * MiB;
constexpr size_t WS_YA = 128 * MiB;
constexpr size_t WS_PP = 160 * MiB;
constexpr size_t WS_Q = 192 * MiB, WS_K = 240 * MiB, WS_V = 288 * MiB;
constexpr size_t WS_G = 336 * MiB;
constexpr size_t WS_MERGED = 192 * MiB;
constexpr size_t WS_HID = 192 * MiB;
constexpr size_t WS_END = 464 * MiB;
static_assert(WS_W1IN + (size_t)NFF * DM * 2 <= WS_W1OUT && WS_W1OUT + (size_t)DM * DFF * 2 <= WS_WIN && WS_WIN + (size_t)NIN * DM * 2 <= WS_WM && WS_WM + (size_t)2048 * 512 * 2 <= WS_WOUT &&
              WS_WOUT + (size_t)DM * DM * 2 <= WS_W2IN && WS_W2IN + (size_t)NFF * DM * 2 <= WS_W2OUT && WS_W2OUT + (size_t)DM * DFF * 2 <= WS_XA, "weight map");
static_assert(WS_HID + (size_t)M * DFF * 2 <= WS_END && WS_G + (size_t)M * 2048 * 2 <= WS_END && WS_MERGED + (size_t)M * DM * 2 <= WS_V, "activation map");
constexpr int CW_BAR = 4096;

constexpr int RING_OFF = 0, RING_BYTES = 131072;
constexpr int LDSCTL_OFF = RING_BYTES, MISC_OFF = LDSCTL_OFF + 320;
constexpr int LDS_BYTES = 147456;
static_assert(MISC_OFF + 128 <= LDS_BYTES, "LDS map");

#define GAS __attribute__((address_space(1)))
#define LAS __attribute__((address_space(3)))
typedef unsigned short bf16;
typedef unsigned v4u __attribute__((ext_vector_type(4)));
typedef float f32x4 __attribute__((ext_vector_type(4)));
typedef short bf16x8 __attribute__((ext_vector_type(8)));
typedef GAS unsigned gu32;
typedef GAS unsigned long long gu64;
#define RLX_AGENT __ATOMIC_RELAXED, __HIP_MEMORY_SCOPE_AGENT
#define LDS_WAIT() asm volatile("s_waitcnt lgkmcnt(0)" ::: "memory")
#define VM_WAIT() asm volatile("s_waitcnt vmcnt(0)" ::: "memory")
__device__ __forceinline__ unsigned long long rt() { return __builtin_amdgcn_s_memrealtime(); }
__device__ __forceinline__ unsigned f2bf(float f) { unsigned u = __builtin_bit_cast(unsigned, f); return (u + 0x7fffu + ((u >> 16) & 1u)) >> 16; }
__device__ __forceinline__ unsigned pk2(float lo, float hi) { return f2bf(lo) | (f2bf(hi) << 16); }

#define XB_TMO      128
#define XB_XCNT(j)  (256  + 64 * (j))
#define XB_XSUB(j)  (1280 + 64 * (j))
#define XB_XGEN(j)  (2304 + 64 * (j))
#define XB_TOP      3328
#define XB_TOPGEN   3392
#define XCD_BAR_WORDS 3456
#define XB_SPIN_CAP (1u << 18)

__device__ __forceinline__ unsigned xb_ld(unsigned* p)              { return __hip_atomic_load(p, __ATOMIC_RELAXED, __HIP_MEMORY_SCOPE_AGENT); }
__device__ __forceinline__ unsigned xb_add(unsigned* p, unsigned v) { return __hip_atomic_fetch_add(p, v, __ATOMIC_RELAXED, __HIP_MEMORY_SCOPE_AGENT); }
__device__ __forceinline__ unsigned xb_xcc_id() { return (unsigned)__builtin_amdgcn_s_getreg((3 << 11) | 20) & 0xFu; }
#define XB_SPIN(cond, bar) do { unsigned _sp = 0; while (cond) { __builtin_amdgcn_s_sleep(1); \
    if ((++_sp & 255u) == 0u) { if (xb_ld(&(bar)[XB_TMO])) break; if (_sp > XB_SPIN_CAP) { atomicAdd(&(bar)[XB_TMO], 1u); break; } } } } while (0)

struct XcdBarrier {
    unsigned* bar; unsigned x;
    volatile LAS unsigned* st;
};

__device__ __forceinline__ XcdBarrier xcd_barrier_post(unsigned* bar, volatile LAS unsigned* st) {
    XcdBarrier b; b.bar = bar; b.x = xb_xcc_id(); b.st = st;
    if (threadIdx.x == 0) (void)xb_add(&bar[XB_XCNT(b.x)], 1u);
    return b;
}
__device__ __forceinline__ void xcd_barrier_complete(unsigned* bar, unsigned x, unsigned& nloc, unsigned& nx) {
    const unsigned G = gridDim.x * gridDim.y * gridDim.z;
    unsigned sum, cnt, mine, sp = 0u;
    for (;;) {
        sum = 0u; cnt = 0u; mine = 0u;
#pragma unroll
        for (unsigned j = 0; j < 16; ++j) { const unsigned c = xb_ld(&bar[XB_XCNT(j)]); sum += c; cnt += (c > 0u) ? 1u : 0u; mine = (j == x) ? c : mine; }
        if (sum == G) break;
        __builtin_amdgcn_s_sleep(1);
        if ((++sp & 255u) == 0u) { if (xb_ld(&bar[XB_TMO])) break; if (sp > XB_SPIN_CAP) { atomicAdd(&bar[XB_TMO], 1u); break; } }
    }
    nloc = mine > 0u ? mine : 1u; nx = cnt > 0u ? cnt : 1u;
}

__device__ __forceinline__ void xcd_barrier(const XcdBarrier& b) {
    asm volatile("s_waitcnt vmcnt(0)" ::: "memory");
    __syncthreads();
    if (threadIdx.x == 0) {
        unsigned* bar = b.bar;
        __builtin_amdgcn_s_waitcnt(0);
        unsigned nloc = b.st[0], nx = b.st[1];
        if (nloc == 0u) { xcd_barrier_complete(bar, b.x, nloc, nx); b.st[0] = nloc; b.st[1] = nx; }
        const unsigned old = xb_add(&bar[XB_XSUB(b.x)], 1u);
        const unsigned gen = old / nloc;
        if (old + 1u == (gen + 1u) * nloc) {
            __builtin_amdgcn_fence(__ATOMIC_RELEASE, "agent");
            asm volatile("s_waitcnt vmcnt(0)" ::: "memory");
            const unsigned og = xb_add(&bar[XB_TOP], 1u);
            const unsigned tg = og / nx;
            if (og + 1u == (tg + 1u) * nx) xb_add(&bar[XB_TOPGEN], 1u);
            else XB_SPIN(xb_ld(&bar[XB_TOPGEN]) == tg, bar);
            __builtin_amdgcn_fence(__ATOMIC_ACQUIRE, "agent");
            xb_add(&bar[XB_XGEN(b.x)], 1u);
            asm volatile("s_waitcnt vmcnt(0)" ::: "memory");
        } else {
            XB_SPIN(xb_ld(&bar[XB_XGEN(b.x)]) == gen, bar);
            __builtin_amdgcn_fence(__ATOMIC_ACQUIRE, "agent");
            asm volatile("s_waitcnt vmcnt(0)" ::: "memory");
        }
    }
    __syncthreads();
}

struct Frame {
    LAS unsigned char* lds;
    volatile LAS unsigned* MISC;
    gu32* ctl;
    int tid, lane, wave;
    int vcu, G;
};
__device__ __forceinline__ float wave_sum(float v) {
#pragma unroll
    for (int o = 1; o < 64; o <<= 1) v += __shfl_xor(v, o);
    return v;
}
__device__ __forceinline__ float wave_max(float v) {
#pragma unroll
    for (int o = 1; o < 64; o <<= 1) v = fmaxf(v, __shfl_xor(v, o));
    return v;
}
__device__ __forceinline__ float silu_f(float a) { return a * mk::sigmoid_f(a); }

__device__ __forceinline__ void tr_item(const float* W, int N, int k0, int n0, bf16* WT, int Kd, int dst_row0, int dst_k0, LAS float* scr, int lane) {
#pragma unroll 8
    for (int i = 0; i < 32; ++i) { const int kk = 2 * i + (lane >> 5); scr[kk * 33 + (lane & 31)] = W[(size_t)(k0 + kk) * N + n0 + (lane & 31)]; }
    LDS_WAIT(); asm volatile("" ::: "memory");
    const int c = lane & 7;
#pragma unroll
    for (int j = 0; j < 4; ++j) { const int n = (lane >> 3) + 8 * j; const LAS float* s = scr + (8 * c) * 33 + n;
        v4u o; o.x = pk2(s[0 * 33], s[1 * 33]); o.y = pk2(s[2 * 33], s[3 * 33]); o.z = pk2(s[4 * 33], s[5 * 33]); o.w = pk2(s[6 * 33], s[7 * 33]);
        *(v4u*)(WT + (size_t)(dst_row0 + n) * Kd + dst_k0 + 8 * c) = o; }
    LDS_WAIT(); asm volatile("" ::: "memory");
}
__device__ __forceinline__ void zero_item(bf16* WT, int Kd, int dst_row0, int dst_k0, int lane) {
    const int c = lane & 7;
#pragma unroll
    for (int j = 0; j < 4; ++j) { const int n = (lane >> 3) + 8 * j; *(v4u*)(WT + (size_t)(dst_row0 + n) * Kd + dst_k0 + 8 * c) = (v4u){0u, 0u, 0u, 0u}; }
}
__device__ __forceinline__ int ffn_row0(int n0) { const int half = n0 >= DFF ? 1 : 0, j = n0 - half * DFF; return 256 * (j >> 7) + 128 * half + (j & 127); }
__device__ __forceinline__ int inproj_row0(int n0) {
    if (n0 < 1024) { const int e = n0 - 256, head = e >> 6, bj = (e >> 5) & 1; return 256 * (1 + (head >> 2)) + 128 * bj + 32 * (head & 3); }
    if (n0 < 1792) { const int e = n0 - 1024, head = e >> 6, bj = (e >> 5) & 1; return 256 * (4 + (head >> 2)) + 128 * bj + 32 * (head & 3); }
    return n0;
}

struct Ptrs {
    const float *x, *c; const int* pos; const float *w_ada, *b_ada, *g1, *w1in, *w1out, *g2, *w_in, *w_pool, *pool_scale, *w_pb, *w_ab, *w_out, *g3, *w2in, *w2out, *gf;
    float* out; unsigned char* ws;
};

__constant__ float INV_FREQ[32] = {
    1.0f, 0.74989420933f, 0.56234132519f, 0.42169650343f, 0.31622776602f, 0.23713737057f, 0.17782794100f, 0.13335214322f,
    0.1f, 0.074989420933f, 0.056234132519f, 0.042169650343f, 0.031622776602f, 0.023713737057f, 0.017782794100f, 0.013335214322f,
    0.01f, 0.0074989420933f, 0.0056234132519f, 0.0042169650343f, 0.0031622776602f, 0.0023713737057f, 0.0017782794100f, 0.0013335214322f,
    0.001f, 0.00074989420933f, 0.00056234132519f, 0.00042169650343f, 0.00031622776602f, 0.00023713737057f, 0.00017782794100f, 0.00013335214322f };

__device__ __forceinline__ void p0_prologue(Frame& F, const Ptrs& P) {
    unsigned char* ws = P.ws;
    float* mod = (float*)(ws + WS_MOD);
    {
        LAS float* cond = (LAS float*)(F.lds + RING_OFF);
        LAS float* red = (LAS float*)(F.lds + RING_OFF + 16384);
        for (int i = F.tid; i < NB * DM; i += NWAVES * 64) { const int b = i >> 10, k = i & 1023; cond[k * 4 + b] = silu_f(P.c[i]); }
        __syncthreads();
        for (int item = F.vcu; item < NMOD / 64; item += F.G) {
            const int n = item * 64 + F.lane; float a0 = 0.f, a1 = 0.f, a2 = 0.f, a3 = 0.f;
            const float* wp = P.w_ada + (size_t)(F.wave * 128) * NMOD + n;
#pragma unroll 8
            for (int k = 0; k < 128; ++k) { const float w = wp[(size_t)k * NMOD]; const LAS float* cp = cond + (F.wave * 128 + k) * 4; a0 += cp[0] * w; a1 += cp[1] * w; a2 += cp[2] * w; a3 += cp[3] * w; }
            red[(F.wave * 4 + 0) * 64 + F.lane] = a0; red[(F.wave * 4 + 1) * 64 + F.lane] = a1; red[(F.wave * 4 + 2) * 64 + F.lane] = a2; red[(F.wave * 4 + 3) * 64 + F.lane] = a3;
            __syncthreads();
            if (F.wave < 4) { float s = P.b_ada[n];
#pragma unroll
                for (int w = 0; w < 8; ++w) s += red[(w * 4 + F.wave) * 64 + F.lane];
                mod[(size_t)F.wave * NMOD + n] = s; }
            __syncthreads();
        }
    }
    LAS float* scr = (LAS float*)(F.lds + RING_OFF + F.wave * 16384);
    const int gw = F.vcu * NWAVES + F.wave, NGW = F.G * NWAVES;
    constexpr int I_FIN = (DM / 64) * (NFF / 32);
    constexpr int I_FOUT = (DFF / 64) * (DM / 32);
    constexpr int I_IN = (DM / 64) * ((NIN - 256) / 32);
    constexpr int I_BR = (256 / 64) * (DM / 32);
    constexpr int I_OUT = (DM / 64) * (DM / 32);
    constexpr int I_POOL = (DM / 64) * (256 / 32);
    constexpr int I_CS = M / 64;
    constexpr int NITEMS = 2 * I_FIN + 2 * I_FOUT + I_IN + 2 * I_BR + I_OUT + I_POOL + I_CS;
    bf16* W1IN = (bf16*)(ws + WS_W1IN); bf16* W1OUT = (bf16*)(ws + WS_W1OUT); bf16* WIN = (bf16*)(ws + WS_WIN); bf16* WM = (bf16*)(ws + WS_WM);
    bf16* WOUT = (bf16*)(ws + WS_WOUT); bf16* W2IN = (bf16*)(ws + WS_W2IN); bf16* W2OUT = (bf16*)(ws + WS_W2OUT);
    for (int it = gw; it < NITEMS; it += NGW) {
        int r = it;
        if (r < 2 * I_FIN) { const bool second = r >= I_FIN; if (second) r -= I_FIN; const int nblk = NFF / 32, kb = r / nblk, nb = r % nblk;
            tr_item(second ? P.w2in : P.w1in, NFF, 64 * kb, 32 * nb, second ? W2IN : W1IN, DM, ffn_row0(32 * nb), 64 * kb, scr, F.lane); continue; }
        r -= 2 * I_FIN;
        if (r < 2 * I_FOUT) { const bool second = r >= I_FOUT; if (second) r -= I_FOUT; const int nblk = DM / 32, kb = r / nblk, nb = r % nblk;
            tr_item(second ? P.w2out : P.w1out, DM, 64 * kb, 32 * nb, second ? W2OUT : W1OUT, DFF, 32 * nb, 64 * kb, scr, F.lane); continue; }
        r -= 2 * I_FOUT;
        if (r < I_IN) { const int nblk = (NIN - 256) / 32, kb = r / nblk, nb = r % nblk, n0 = 256 + 32 * nb;
            tr_item(P.w_in, NIN, 64 * kb, n0, WIN, DM, inproj_row0(n0), 64 * kb, scr, F.lane); continue; }
        r -= I_IN;
        if (r < 2 * I_BR) { const bool attn = r >= I_BR; if (attn) r -= I_BR; const int nblk = DM / 32, kb = r / nblk, nb = r % nblk, n0 = 32 * nb;
            const int row0 = 256 * (n0 >> 7) + (attn ? 128 : 0) + (n0 & 127);
            tr_item(attn ? P.w_ab : P.w_pb, DM, 64 * kb, n0, WM, 512, row0, (attn ? 256 : 0) + 64 * kb, scr, F.lane);
            zero_item(WM, 512, row0, (attn ? 0 : 256) + 64 * kb, F.lane); continue; }
        r -= 2 * I_BR;
        if (r < I_OUT) { const int nblk = DM / 32, kb = r / nblk, nb = r % nblk;
            tr_item(P.w_out, DM, 64 * kb, 32 * nb, WOUT, DM, 32 * nb, 64 * kb, scr, F.lane); continue; }
        r -= I_OUT;
        if (r < I_POOL) {
            const int kb = r / 8, nb = r % 8, g = nb >> 1, dd0 = (nb & 1) * 32, k = 64 * kb + F.lane;
            const float* wr = P.w_in + (size_t)k * NIN + 64 * g; const float* wp = P.w_pool + (size_t)g * 4096 + dd0;
            float o[32];
#pragma unroll
            for (int d = 0; d < 32; ++d) o[d] = 0.f;
            for (int c4 = 0; c4 < 16; ++c4) { const f32x4 a = *(const f32x4*)(wr + 4 * c4);
#pragma unroll
                for (int ci = 0; ci < 4; ++ci) { const float av = a[ci]; const float* wq = wp + (size_t)(4 * c4 + ci) * 64;
#pragma unroll
                    for (int d = 0; d < 32; ++d) o[d] += av * wq[d]; } }
#pragma unroll
            for (int d = 0; d < 32; ++d) { const int np = 32 * nb + d; WIN[(size_t)np * DM + k] = (bf16)f2bf(o[d] * P.pool_scale[np]); }
            continue; }
        r -= I_POOL;
        {
            const int f = F.lane & 31; const float invf = INV_FREQ[f];
            float* cs = (float*)(ws + WS_CS);
            for (int i = 0; i < 32; ++i) { const int m = 64 * r + 2 * i + (F.lane >> 5);
                const float ang = (float)P.pos[m] * invf;
                const double a = (double)ang; const double kq = rint(a * 0.15915494309189535); const double red = fma(-kq, 6.283185307179586, a) - kq * 2.4492935982947064e-16;
                const float rr = (float)red;
                cs[(size_t)m * 64 + f] = cosf(rr); cs[(size_t)m * 64 + 32 + f] = sinf(rr); }
        }
    }
}

__device__ __forceinline__ void p1_prologue(Frame& F, const Ptrs& P) {
    unsigned char* ws = P.ws; const float* mod = (const float*)(ws + WS_MOD);
    const int gw = F.vcu * NWAVES + F.wave, NGW = F.G * NWAVES;
    bf16* XA = (bf16*)(ws + WS_XA);
    for (int m = gw; m < M; m += NGW) {
        const int b = m / SEQ; const f32x4* xr = (const f32x4*)(P.x + (size_t)m * DM) + F.lane;
        f32x4 v[4]; float s = 0.f;
#pragma unroll
        for (int j = 0; j < 4; ++j) { v[j] = xr[64 * j]; s += (v[j].x * v[j].x + v[j].y * v[j].y) + (v[j].z * v[j].z + v[j].w * v[j].w); }
        const float rstd = __builtin_amdgcn_rsqf(wave_sum(s) * (1.f / DM) + mk::EPS);
        unsigned long long* o8 = (unsigned long long*)(XA + (size_t)m * DM) + F.lane;
#pragma unroll
        for (int j = 0; j < 4; ++j) { const int c = 4 * F.lane + 256 * j;
            const f32x4 g = *(const f32x4*)(P.g1 + c), sh = *(const f32x4*)(mod + (size_t)b * NMOD + c), sc = *(const f32x4*)(mod + (size_t)b * NMOD + DM + c);
            const f32x4 y = (v[j] * rstd * g) * (sc + 1.0f) + sh;
            o8[64 * j] = (unsigned long long)pk2(y.x, y.y) | ((unsigned long long)pk2(y.z, y.w) << 32); }
    }
    for (int it = gw; it < NIN + NFF; it += NGW) {
        const bool second = it >= NIN; const int n = second ? it - NIN : it;
        const bf16* wrow = (const bf16*)(ws + (second ? WS_W2IN : WS_WIN)) + (size_t)n * DM + 16 * F.lane;
        const v4u w0 = *(const v4u*)wrow, w1 = *(const v4u*)(wrow + 8);
        float wv[16] = { mk::bf_lo(w0.x), mk::bf_hi(w0.x), mk::bf_lo(w0.y), mk::bf_hi(w0.y), mk::bf_lo(w0.z), mk::bf_hi(w0.z), mk::bf_lo(w0.w), mk::bf_hi(w0.w),
                         mk::bf_lo(w1.x), mk::bf_hi(w1.x), mk::bf_lo(w1.y), mk::bf_hi(w1.y), mk::bf_lo(w1.z), mk::bf_hi(w1.z), mk::bf_lo(w1.w), mk::bf_hi(w1.w) };
        float* dst = (float*)(ws + (second ? WS_BIAS3 : WS_BIAS2));
        const int shoff = (second ? 6 : 3) * DM;
#pragma unroll
        for (int b = 0; b < NB; ++b) { const float* sh = mod + (size_t)b * NMOD + shoff + 16 * F.lane; float s = 0.f;
#pragma unroll
            for (int q = 0; q < 4; ++q) { const f32x4 t = *(const f32x4*)(sh + 4 * q); s += (t.x * wv[4 * q] + t.y * wv[4 * q + 1]) + (t.z * wv[4 * q + 2] + t.w * wv[4 * q + 3]); }
            s = wave_sum(s);
            if (F.lane == 0) dst[(size_t)b * (second ? NFF : NIN) + n] = s; }
    }
}

__device__ __forceinline__ float dot_bf16x8(const v4u q, const v4u k, float s) {
    s += mk::bf_lo(q.x) * mk::bf_lo(k.x); s += mk::bf_hi(q.x) * mk::bf_hi(k.x); s += mk::bf_lo(q.y) * mk::bf_lo(k.y); s += mk::bf_hi(q.y) * mk::bf_hi(k.y);
    s += mk::bf_lo(q.z) * mk::bf_lo(k.z); s += mk::bf_hi(q.z) * mk::bf_hi(k.z); s += mk::bf_lo(q.w) * mk::bf_lo(k.w); s += mk::bf_hi(q.w) * mk::bf_hi(k.w); return s;
}
__device__ __forceinline__ void p5_mixers_naive(Frame& F, const Ptrs& P) {
    unsigned char* ws = P.ws;
    const float* PP = (const float*)(ws + WS_PP); bf16* YA = (bf16*)(ws + WS_YA);
    const bf16* Q = (const bf16*)(ws + WS_Q); const bf16* K = (const bf16*)(ws + WS_K); const bf16* V = (const bf16*)(ws + WS_V);
    const int gw = F.vcu * NWAVES + F.wave, NGW = F.G * NWAVES;
    for (int m = gw; m < M; m += NGW) {
        const int t = m % SEQ, w = 2 << (F.lane >> 4), cnt = (t + 1 < w) ? t + 1 : w;
        const float* p = PP + (size_t)m * 256 + 4 * F.lane;
        const f32x4 cur = *(const f32x4*)p; f32x4 s = cur;
        for (int j = 1; j < cnt; ++j) s += *(const f32x4*)(p - (size_t)j * 256);
        const f32x4 y = s * (1.0f / (float)cnt) - cur;
        *(unsigned long long*)(YA + (size_t)m * 512 + 4 * F.lane) = (unsigned long long)pk2(y.x, y.y) | ((unsigned long long)pk2(y.z, y.w) << 32);
    }
    for (int it = gw; it < M * 4; it += NGW) {
        const int m = it >> 2, j = it & 3, t = m % SEQ;
        float Mrun = -1e30f, Lrun = 0.f, o = 0.f;
        for (int g = 0; g < 3; ++g) {
            const int h = 4 * g + j, dsh = 2 * g, dil = 1 << dsh, i = t >> dsh, nk = (i < 128 ? i : 128) + 1;
            const bf16* qp = Q + (size_t)m * QKVW + h * 64;
            v4u qv[8];
#pragma unroll
            for (int c = 0; c < 8; ++c) qv[c] = *(const v4u*)(qp + 8 * c);
            float sc[3];
#pragma unroll
            for (int sl = 0; sl < 3; ++sl) { const int jj = F.lane + 64 * sl; const bool valid = jj < nk; const int row = valid ? m - jj * dil : m;
                const bf16* kp = K + (size_t)row * QKVW + h * 64; float s = 0.f;
#pragma unroll
                for (int c = 0; c < 8; ++c) s = dot_bf16x8(qv[c], *(const v4u*)(kp + 8 * c), s);
                sc[sl] = valid ? s : -1e30f; }
            const float mx = wave_max(fmaxf(fmaxf(sc[0], sc[1]), sc[2]));
            const float Mn = fmaxf(Mrun, mx), f = __builtin_amdgcn_exp2f(Mrun - Mn);
            float p[3];
#pragma unroll
            for (int sl = 0; sl < 3; ++sl) p[sl] = (F.lane + 64 * sl < nk) ? __builtin_amdgcn_exp2f(sc[sl] - Mn) : 0.f;
            const float l = wave_sum(p[0] + p[1] + p[2]);
            Lrun = Lrun * f + l; o *= f; Mrun = Mn;
            const unsigned short* vp = (const unsigned short*)V + (size_t)m * QKVW + h * 64 + F.lane;
#pragma unroll
            for (int sl = 0; sl < 3; ++sl) { const int lim = (nk - 64 * sl) < 64 ? (nk - 64 * sl) : 64;
                for (int jj = 0; jj < lim; ++jj) { const float pj = __uint_as_float((unsigned)__builtin_amdgcn_readlane((int)__float_as_uint(p[sl]), jj));
                    const unsigned vv = vp[-(ptrdiff_t)((size_t)(jj + 64 * sl) * dil * QKVW)]; o += pj * __uint_as_float(vv << 16); } }
        }
        const float y = o / Lrun;
        YA[(size_t)m * 512 + 256 + j * 64 + F.lane] = (bf16)f2bf(y);
    }
}

__device__ __forceinline__ void p10_final_norm(Frame& F, const Ptrs& P) {
    const int gw = F.vcu * NWAVES + F.wave, NGW = F.G * NWAVES;
    for (int m = gw; m < M; m += NGW) {
        f32x4* xr = (f32x4*)(P.out + (size_t)m * DM) + F.lane;
        f32x4 v[4]; float s = 0.f;
#pragma unroll
        for (int j = 0; j < 4; ++j) { v[j] = xr[64 * j]; s += (v[j].x * v[j].x + v[j].y * v[j].y) + (v[j].z * v[j].z + v[j].w * v[j].w); }
        const float rstd = __builtin_amdgcn_rsqf(wave_sum(s) * (1.f / DM) + mk::EPS);
#pragma unroll
        for (int j = 0; j < 4; ++j) { const f32x4 g = *(const f32x4*)(P.gf + 4 * F.lane + 256 * j); xr[64 * j] = v[j] * rstd * g; }
    }
}


#ifdef MK_PROBE
constexpr int CW_DBG = 32768;
__device__ __forceinline__ void probe_rows(Frame& F, const float* h, const float* ssq, int slot) {
    const int gw = F.vcu * NWAVES + F.wave, NGW = F.G * NWAVES;
    for (int m = gw; m < M; m += NGW) {
        const f32x4* xr = (const f32x4*)(h + (size_t)m * DM) + F.lane; float s = 0.f;
#pragma unroll
        for (int j = 0; j < 4; ++j) { const f32x4 v = xr[64 * j]; s += (v.x * v.x + v.y * v.y) + (v.z * v.z + v.w * v.w); }
        s = wave_sum(s);
        float t = 0.f; if (ssq) { t = (F.lane < 16) ? ssq[(size_t)m * 16 + F.lane] : 0.f; t = wave_sum(t); }
        if (F.lane == 0) { if (!(s * (1.f / DM) <= 9.0f)) atomicAdd((unsigned*)(F.ctl + CW_DBG + slot), 1u);
            if (ssq && !(fabsf(t - s) <= 1e-3f * s)) atomicAdd((unsigned*)(F.ctl + CW_DBG + slot + 1), 1u); }
    }
}

__device__ __forceinline__ void probe_corr(Frame& F, const float* a, const float* b, const bf16* ab, int slot) {
    const int gw = F.vcu * NWAVES + F.wave, NGW = F.G * NWAVES;
    for (int m = gw; m < M; m += NGW) {
        float sxx = 0.f, soo = 0.f, sxo = 0.f;
#pragma unroll
        for (int j = 0; j < 4; ++j) { const int c = 4 * F.lane + 256 * j; const f32x4 y = *(const f32x4*)(b + (size_t)m * DM + c); f32x4 x;
            if (ab) { const unsigned long long w = *(const unsigned long long*)(ab + (size_t)m * DM + c); x = (f32x4){mk::bf_lo((unsigned)w), mk::bf_hi((unsigned)w), mk::bf_lo((unsigned)(w >> 32)), mk::bf_hi((unsigned)(w >> 32))}; }
            else x = *(const f32x4*)(a + (size_t)m * DM + c);
            sxx += x.x * x.x + x.y * x.y + x.z * x.z + x.w * x.w; soo += y.x * y.x + y.y * y.y + y.z * y.z + y.w * y.w; sxo += x.x * y.x + x.y * y.y + x.z * y.z + x.w * y.w; }
        sxx = wave_sum(sxx); soo = wave_sum(soo); sxo = wave_sum(sxo);
        if (F.lane == 0 && !(sxo > 0.8f * sqrtf(sxx * soo))) { atomicAdd((unsigned*)(F.ctl + CW_DBG + 16 + slot), 1u); if ((m & 2047) == 1601) atomicAdd((unsigned*)(F.ctl + CW_DBG + 16 + 8 + slot), 1u); }
    }
}

__device__ __forceinline__ void probe_mag(Frame& F, const float* a, const bf16* ab, int pitch, int c0, float lim, int slot) {
    const int gw = F.vcu * NWAVES + F.wave, NGW = F.G * NWAVES;
    for (int m = gw; m < M; m += NGW) {
        f32x4 x;
        if (ab) { const unsigned long long w = *(const unsigned long long*)(ab + (size_t)m * pitch + c0 + 4 * F.lane); x = (f32x4){mk::bf_lo((unsigned)w), mk::bf_hi((unsigned)w), mk::bf_lo((unsigned)(w >> 32)), mk::bf_hi((unsigned)(w >> 32))}; }
        else x = *(const f32x4*)(a + (size_t)m * pitch + c0 + 4 * F.lane);
        const float s = wave_sum(x.x * x.x + x.y * x.y + x.z * x.z + x.w * x.w);
        if (F.lane == 0 && !(s * (1.f / 256.f) <= lim)) { atomicAdd((unsigned*)(F.ctl + CW_DBG + 16 + slot), 1u); if ((m & 2047) == 1601) atomicAdd((unsigned*)(F.ctl + CW_DBG + 16 + 8 + slot), 1u); }
    }
}

__device__ __forceinline__ void probe_max(Frame& F, const bf16* ab, int pitch, int c0, int ncols, int slot) {
    const int gw = F.vcu * NWAVES + F.wave, NGW = F.G * NWAVES; float mx = 0.f;
    for (int m = gw; m < M; m += NGW) for (int c = 4 * F.lane; c < ncols; c += 256) {
        const unsigned long long w = *(const unsigned long long*)(ab + (size_t)m * pitch + c0 + c);
        mx = fmaxf(mx, fmaxf(fmaxf(fabsf(mk::bf_lo((unsigned)w)), fabsf(mk::bf_hi((unsigned)w))), fmaxf(fabsf(mk::bf_lo((unsigned)(w >> 32))), fabsf(mk::bf_hi((unsigned)(w >> 32)))))); }
    mx = wave_max(mx); if (F.lane == 0) atomicMax((unsigned*)(F.ctl + CW_DBG + 32 + slot), __float_as_uint(mx));
}

__device__ __forceinline__ void probe_gcount(Frame& F, const bf16* ab, int slot) {
    const int gw = F.vcu * NWAVES + F.wave, NGW = F.G * NWAVES;
    for (int m = gw; m < M; m += NGW) { unsigned n = 0;
        for (int c = 4 * F.lane; c < 2048; c += 256) {
            const unsigned long long w = *(const unsigned long long*)(ab + (size_t)m * 2048 + c);
            const float v0 = mk::bf_lo((unsigned)w), v1 = mk::bf_hi((unsigned)w), v2 = mk::bf_lo((unsigned)(w >> 32)), v3 = mk::bf_hi((unsigned)(w >> 32));
            n += (!(v0 >= 0.f && v0 <= 1.01f)) + (!(v1 >= 0.f && v1 <= 1.01f)) + (!(v2 >= 0.f && v2 <= 1.01f)) + (!(v3 >= 0.f && v3 <= 1.01f)); }
        if (n) atomicAdd((unsigned*)(F.ctl + CW_DBG + 48 + slot + (m >= 8192 ? 1 : 0)), n); }
}

__device__ __forceinline__ void probe_gtile(Frame& F, const bf16* ab) {
    const int gw = F.vcu * NWAVES + F.wave, NGW = F.G * NWAVES;
    for (int m = gw; m < M; m += NGW) {
        for (int ct = 0; ct < 8; ++ct) {
            const unsigned long long w = *(const unsigned long long*)(ab + (size_t)m * 2048 + ct * 256 + 4 * F.lane);
            const float v0 = mk::bf_lo((unsigned)w), v1 = mk::bf_hi((unsigned)w), v2 = mk::bf_lo((unsigned)(w >> 32)), v3 = mk::bf_hi((unsigned)(w >> 32));
            const int n = (!(v0 >= 0.f && v0 <= 1.01f)) + (!(v1 >= 0.f && v1 <= 1.01f)) + (!(v2 >= 0.f && v2 <= 1.01f)) + (!(v3 >= 0.f && v3 <= 1.01f));
            if (__any(n != 0) && F.lane == 0) { const unsigned idx = (unsigned)((m >> 8) * 8 + ct); atomicMax((unsigned*)(F.ctl + CW_DBG + 56), idx + 1u); atomicMax((unsigned*)(F.ctl + CW_DBG + 57), 4096u - idx); atomicAdd((unsigned*)(F.ctl + CW_DBG + 58), 1u); if (idx != 0u && idx != 1023u) atomicMax((unsigned*)(F.ctl + CW_DBG + 59), idx + 1u); } } }
}
#endif

struct Args { Ptrs p; int ph_lo, ph_hi, li, pad; };
__global__ void __launch_bounds__(NWAVES * 64, 2) mk_fwd(Args args) {
    extern __shared__ __attribute__((aligned(16))) unsigned char lds[];
    Frame F;
    F.lds = (LAS unsigned char*)lds;
    F.MISC = (volatile LAS unsigned*)(F.lds + MISC_OFF);
    F.tid = threadIdx.x; F.lane = F.tid & 63; F.wave = __builtin_amdgcn_readfirstlane(F.tid >> 6);
    F.G = gridDim.x; { const int bx = blockIdx.x; F.vcu = (F.G % 8 == 0) ? (bx % 8) * (F.G / 8) + bx / 8 : bx; }
    const Ptrs& P = args.p;
    unsigned char* ws = P.ws;
    F.ctl = (gu32*)(ws + WS_CTL);
    for (int u = F.tid; u < (LDS_BYTES - LDSCTL_OFF) / 4; u += NWAVES * 64) ((LAS unsigned*)(F.lds + LDSCTL_OFF))[u] = 0u;
    __syncthreads();
    XcdBarrier bar; bar.bar = (unsigned*)(F.ctl + CW_BAR); bar.x = 0; bar.st = nullptr;
    if (N_LAUNCHES == 1) bar = xcd_barrier_post((unsigned*)(F.ctl + CW_BAR), F.MISC + 8);
#define GRID_BAR() do { if (N_LAUNCHES == 1) xcd_barrier(bar); } while (0)
    const int lo = args.ph_lo, hi = args.ph_hi;
#define IN(k) (lo <= (k) && (k) < hi)
#define BOTH(k) (IN(k) && IN((k) + 1))
    float* mod = (float*)(ws + WS_MOD);
    bf16* XA = (bf16*)(ws + WS_XA); bf16* HID = (bf16*)(ws + WS_HID);
    float* SSQ2 = (float*)(ws + WS_SSQ2); float* SSQ3 = (float*)(ws + WS_SSQ3); float* SSQF = (float*)(ws + WS_SSQF);

    if (IN(0)) { p0_prologue(F, P); if (BOTH(0)) GRID_BAR(); }
    if (IN(1)) { p1_prologue(F, P); if (BOTH(1)) GRID_BAR(); }
#ifdef MK_PROBE
#endif
    if (IN(2)) {
        pg8::Gemm g{XA, (const bf16*)(ws + WS_W1IN), M, NFF, DM}; pg8::StaticOrder S; S.init(M, NFF, F.G, (int)blockIdx.x);
        mk::EpiSwiglu<false> E{HID, nullptr, nullptr};
        pg8::gemm_phase<mk::EpiSwiglu<false>, pg8::StaticOrder, true, true>(F.lds + RING_OFF, g, S, E);
        if (BOTH(2)) GRID_BAR();
    }
    if (IN(3)) {
        pg8::Gemm g{HID, (const bf16*)(ws + WS_W1OUT), M, DM, DFF}; pg8::StaticOrder S; S.init(M, DM, F.G, (int)blockIdx.x);
        mk::EpiResid<true, true> E{P.x, P.out, mod + 2 * DM, XA, P.g2, mod + 4 * DM, SSQ2};
        pg8::gemm_phase<mk::EpiResid<true, true>, pg8::StaticOrder, true, true>(F.lds + RING_OFF, g, S, E);
        if (BOTH(3)) GRID_BAR();
    }
    if (IN(4)) {
#ifdef MK_PROBE
#endif
        pg8::Gemm g{XA, (const bf16*)(ws + WS_WIN), M, NIN, DM}; pg8::StaticOrder S; S.init(M, NIN, F.G, (int)blockIdx.x);
        mk::EpiInProj E{SSQ2, (const float*)(ws + WS_BIAS2), (const float*)(ws + WS_CS), (float*)(ws + WS_PP), (bf16*)(ws + WS_Q), (bf16*)(ws + WS_K), (bf16*)(ws + WS_V), (bf16*)(ws + WS_G)};
        pg8::gemm_phase<mk::EpiInProj, pg8::StaticOrder, true, true>(F.lds + RING_OFF, g, S, E);
        if (BOTH(4)) GRID_BAR();
    }
#ifdef MK_PROBE
#endif
    if (IN(5)) { p5_mixers_naive(F, P); if (BOTH(5)) GRID_BAR(); }
#ifdef MK_PROBE
    if (IN(5)) probe_gtile(F, (const bf16*)(ws + WS_G));
    if (0) { probe_max(F, (const bf16*)(ws + WS_G), 2048, 0, 2048, 0); probe_max(F, (const bf16*)(ws + WS_YA), 512, 0, 256, 1); probe_max(F, (const bf16*)(ws + WS_YA), 512, 256, 256, 2); probe_max(F, (const bf16*)(ws + WS_MERGED), 1024, 0, 1024, 3); }
#endif
    if (IN(6)) {
        pg8::Gemm g{(const bf16*)(ws + WS_YA), (const bf16*)(ws + WS_WM), M, 2048, 512}; pg8::StaticOrder S; S.init(M, 2048, F.G, (int)blockIdx.x);
        mk::EpiMerge E{(const bf16*)(ws + WS_G), (bf16*)(ws + WS_MERGED)};
        pg8::gemm_phase<mk::EpiMerge, pg8::StaticOrder, true, true>(F.lds + RING_OFF, g, S, E);
        if (BOTH(6)) GRID_BAR();
    }
    if (IN(7)) {
        pg8::Gemm g{(const bf16*)(ws + WS_MERGED), (const bf16*)(ws + WS_WOUT), M, DM, DM}; pg8::StaticOrder S; S.init(M, DM, F.G, (int)blockIdx.x);
        mk::EpiResid<true, false> E{P.out, P.out, mod + 5 * DM, XA, P.g3, mod + 7 * DM, SSQ3};
        pg8::gemm_phase<mk::EpiResid<true, false>, pg8::StaticOrder, true, true>(F.lds + RING_OFF, g, S, E);
        if (BOTH(7)) GRID_BAR();
    }
    if (IN(8)) {
#ifdef MK_PROBE
#endif
        pg8::Gemm g{XA, (const bf16*)(ws + WS_W2IN), M, NFF, DM}; pg8::StaticOrder S; S.init(M, NFF, F.G, (int)blockIdx.x);
        mk::EpiSwiglu<true> E{HID, SSQ3, (const float*)(ws + WS_BIAS3)};
        pg8::gemm_phase<mk::EpiSwiglu<true>, pg8::StaticOrder, true, true>(F.lds + RING_OFF, g, S, E);
        if (BOTH(8)) GRID_BAR();
    }
    if (IN(9)) {
        pg8::Gemm g{HID, (const bf16*)(ws + WS_W2OUT), M, DM, DFF}; pg8::StaticOrder S; S.init(M, DM, F.G, (int)blockIdx.x);
        mk::EpiResid<false, true> E{P.out, P.out, mod + 8 * DM, nullptr, nullptr, nullptr, SSQF};
        pg8::gemm_phase<mk::EpiResid<false, true>, pg8::StaticOrder, true, true>(F.lds + RING_OFF, g, S, E);
        if (BOTH(9)) GRID_BAR();
    }
#ifdef MK_PROBE
    if (IN(10)) { }
    if (IN(11)) { p10_final_norm(F, P); }
    if (IN(12)) {
        const int gw = F.vcu * NWAVES + F.wave, NGW = F.G * NWAVES;
        for (int m = gw; m < M; m += NGW) {
            const f32x4* xr = (const f32x4*)(P.x + (size_t)m * DM) + F.lane; const f32x4* orow = (const f32x4*)(P.out + (size_t)m * DM) + F.lane; float sxx = 0.f, soo = 0.f, sxo = 0.f;
#pragma unroll
            for (int j = 0; j < 4; ++j) { const f32x4 a = xr[64 * j], b = orow[64 * j]; sxx += a.x * a.x + a.y * a.y + a.z * a.z + a.w * a.w; soo += b.x * b.x + b.y * b.y + b.z * b.z + b.w * b.w; sxo += a.x * b.x + a.y * b.y + a.z * b.z + a.w * b.w; }
            sxx = wave_sum(sxx); soo = wave_sum(soo); sxo = wave_sum(sxo);
            if (F.lane == 0 && !(sxo > 0.8f * sqrtf(sxx * soo))) { atomicAdd((unsigned*)(F.ctl + CW_DBG + 16 + 6), 1u); }
        }
    }
    if (IN(13)) { if (blockIdx.x == 0 && F.tid == 0) {
        const unsigned nseg = __hip_atomic_load(F.ctl + CW_DBG + 58, RLX_AGENT), oth = __hip_atomic_load(F.ctl + CW_DBG + 59, RLX_AGENT);
        if (MK_PROBE == 1) { if (nseg) P.out[0] = 1e6f * (float)nseg; }
        else if (oth) { const unsigned sel = oth - 1u; P.out[0] = __builtin_powf(10.f, 4.0f + (float)(sel >> 5)) * (1.0f + 0.25f * (float)(sel & 31u)); } } }
#else
    if (IN(10)) { p10_final_norm(F, P); }
#endif
#undef IN
#undef BOTH
#undef GRID_BAR
}

extern "C" void kernel_launch(void* const* d_in, const int* in_sizes, int n_in, void* d_out, int out_size, void* d_ws, size_t ws_size, hipStream_t stream) {
    static int grid = 0;
    if (grid == 0) {
        if (n_in != 19 || in_sizes[0] != M * DM || out_size != M * DM || ws_size < WS_END) { fprintf(stderr, "kernel_launch: unexpected shapes (n_in %d, in0 %d, out %d, ws %zu); nothing launched\n", n_in, n_in > 0 ? in_sizes[0] : -1, out_size, ws_size); grid = -1; return; }
        int dev = 0, cus = 0, per_cu = 0;
        if (hipGetDevice(&dev) != hipSuccess || hipDeviceGetAttribute(&cus, hipDeviceAttributeMultiprocessorCount, dev) != hipSuccess) { fprintf(stderr, "kernel_launch: device query failed\n"); grid = -1; return; }
        if (hipFuncSetAttribute((const void*)mk_fwd, hipFuncAttributeMaxDynamicSharedMemorySize, LDS_BYTES) != hipSuccess) { fprintf(stderr, "kernel_launch: hipFuncSetAttribute failed\n"); grid = -1; return; }
        if (hipOccupancyMaxActiveBlocksPerMultiprocessor(&per_cu, (const void*)mk_fwd, NWAVES * 64, LDS_BYTES) != hipSuccess || per_cu < 1)
            fprintf(stderr, "kernel_launch: note: occupancy query reports %d workgroups per CU\n", per_cu);
        (void)hipGetLastError();
        grid = cus;
    }
    if (grid < 0) return;
    if (hipMemsetAsync((char*)d_ws + WS_CTL, 0, CTL_ZERO_BYTES, stream) != hipSuccess) { fprintf(stderr, "kernel_launch: memset failed\n"); return; }
    Args a{};
    a.p.x = (const float*)d_in[0]; a.p.c = (const float*)d_in[1]; a.p.pos = (const int*)d_in[2]; a.p.w_ada = (const float*)d_in[3]; a.p.b_ada = (const float*)d_in[4];
    a.p.g1 = (const float*)d_in[5]; a.p.w1in = (const float*)d_in[6]; a.p.w1out = (const float*)d_in[7]; a.p.g2 = (const float*)d_in[8]; a.p.w_in = (const float*)d_in[9];
    a.p.w_pool = (const float*)d_in[10]; a.p.pool_scale = (const float*)d_in[11]; a.p.w_pb = (const float*)d_in[12]; a.p.w_ab = (const float*)d_in[13]; a.p.w_out = (const float*)d_in[14];
    a.p.g3 = (const float*)d_in[15]; a.p.w2in = (const float*)d_in[16]; a.p.w2out = (const float*)d_in[17]; a.p.gf = (const float*)d_in[18];
    a.p.out = (float*)d_out; a.p.ws = (unsigned char*)d_ws;
    for (int li = 0; li < N_LAUNCHES; ++li) {
        a.ph_lo = (N_LAUNCHES == 1) ? 0 : li; a.ph_hi = (N_LAUNCHES == 1) ? NPH : li + 1; a.li = li;
        hipLaunchKernelGGL(mk_fwd, dim3(grid), dim3(NWAVES * 64), LDS_BYTES, stream, a);
        const hipError_t le = hipPeekAtLastError();
        if (le != hipSuccess) { fprintf(stderr, "kernel_launch: launch %d failed: %s\n", li, hipGetErrorName(le)); break; }
    }
}
```

```cpp
#include <hip/hip_runtime.h>
#include <cstdio>
#include <cstdint>
#define MK_N_LAUNCHES 1
namespace pg8 {
#define PG8_LAS __attribute__((address_space(3)))
typedef unsigned short bf16_t;
typedef short bf16x8 __attribute__((ext_vector_type(8)));
typedef float f32x4 __attribute__((ext_vector_type(4)));
typedef unsigned u32x4 __attribute__((ext_vector_type(4)));
constexpr int BM = 256, BK = 64, HALF = 128, HTB = HALF * BK * 2  , STAGE_BYTES = 8 * HTB, NXCD = 8, WGM = 8;

__host__ __device__ __forceinline__ int lds_byte(int r, int c) { const int st = (r >> 4) * 2 + (c >> 5), rr = r & 15, cc = c & 31, ob = rr * 64 + cc * 2; return st * 1024 + (ob ^ (((ob >> 9) & 1) << 5)); }
__host__ __device__ __forceinline__ void stage_rc(int b, int& R, int& C) { const int st = b / 1024, sb = b % 1024, swz = sb ^ (((sb >> 9) & 1) << 5); R = (st >> 1) * 16 + swz / 64; C = (st & 1) * 32 + (swz % 64) / 2; }
__host__ __device__ __forceinline__ int perm32(int rho) { const int n = rho >> 4, i = rho & 15; return 8 * (i >> 2) + 4 * n + (i & 3); }

struct Unit { int pm, pn; };
struct Gemm { const bf16_t* A; const bf16_t* Bt; int M, N, K; };

struct StaticOrder {
    int nM, nN, nwg, G, c;
    __host__ __device__ void init(int M, int N, int G_, int c_) { nM = M / BM; nN = N / BM; nwg = nM * nN; G = G_; c = c_; }
    __host__ __device__ bool next(int i, Unit& u) const {
        const long L = (long)i * G + c; if (L >= nwg) return false;
        int wgid = (int)L; { const int q = nwg / NXCD, r = nwg % NXCD, xcd = wgid % NXCD, off = wgid / NXCD; wgid = (xcd < r ? xcd * (q + 1) : r * (q + 1) + (xcd - r) * q) + off; }
        const int nig = WGM * nN, gid = wgid / nig, fm = gid * WGM, gsz = (nM - fm) < WGM ? (nM - fm) : WGM;
        u.pm = fm + ((wgid % nig) % gsz); u.pn = (wgid % nig) / gsz; return true;
    }
    __device__ __forceinline__ void a_ready(const Unit&) const {}
    __device__ __forceinline__ void done(const Unit&) const {}
};

__device__ __forceinline__ unsigned cvt_pk_bf16(float lo, float hi) { unsigned r; asm volatile("v_cvt_pk_bf16_f32 %0, %1, %2" : "=v"(r) : "v"(lo), "v"(hi)); return r; }
template <class Epi, class Sched, bool ALIGN_EPI = false, bool SP2 = false>
__device__ __forceinline__ void gemm_phase(PG8_LAS unsigned char* lds, const Gemm g, const Sched& S, const Epi& E) {
    const int tid = threadIdx.x, wid = __builtin_amdgcn_readfirstlane(tid >> 6), lane = tid & 63, wr = wid >> 2, wc = wid & 3, fr = lane & 15, fq = lane >> 4;
    const int K = g.K, nt = K / BK;
    unsigned voffA[2], voffB[2];
#pragma unroll
    for (int i = 0; i < 2; ++i) { int R, C; stage_rc(tid * 16 + i * 8192, R, C); const int Rb = Epi::PERM ? ((R & ~31) + perm32(R & 31)) : R;
        voffA[i] = (unsigned)(R * K + C) * 2u; voffB[i] = (unsigned)(Rb * K + C) * 2u; }
    const size_t kstep = (size_t)(BK * 2);
    const size_t hstep = (size_t)HALF * K * 2;
    const size_t tstep = 2 * hstep;
    const unsigned ldsw = (unsigned)wid * 1024u;
    const int aoff = lds_byte(wr * 64 + fr, fq * 8), boff = lds_byte(wc * 32 + fr, fq * 8);
#define PG8_SA(b, h) (((b) * 2 + (h)) * HTB)
#define PG8_SB(b, h) ((4 + (b) * 2 + (h)) * HTB)
#define PG8_STAGE(bufoff, gbase, voff) do { _Pragma("unroll") for (int _i = 0; _i < 2; ++_i) \
        __builtin_amdgcn_global_load_lds((const unsigned*)((const char*)(gbase) + (voff)[_i]), (PG8_LAS unsigned*)(lds + (bufoff) + ldsw + _i * 8192), 16, 0, 0); } while (0)
#define PG8_LDA(dst, b, h) do { _Pragma("unroll") for (int m = 0; m < 4; ++m) _Pragma("unroll") for (int k = 0; k < 2; ++k) dst[m][k] = *(const PG8_LAS bf16x8*)(lds + PG8_SA(b, h) + aoff + m * 2048 + k * 1024); } while (0)
#define PG8_LDB(dst, b, h) do { _Pragma("unroll") for (int n = 0; n < 2; ++n) _Pragma("unroll") for (int k = 0; k < 2; ++k) dst[n][k] = *(const PG8_LAS bf16x8*)(lds + PG8_SB(b, h) + boff + n * 2048 + k * 1024); } while (0)
#define PG8_MMA(ai, bj, At, Bt) do { __builtin_amdgcn_s_setprio(1); _Pragma("unroll") for (int m = 0; m < 4; ++m) _Pragma("unroll") for (int n = 0; n < 2; ++n) _Pragma("unroll") for (int k = 0; k < 2; ++k) \
        acc[ai][bj][m][n] = __builtin_amdgcn_mfma_f32_16x16x32_bf16(Bt[n][k], At[m][k], acc[ai][bj][m][n], 0, 0, 0); __builtin_amdgcn_s_setprio(0); } while (0)
#define PG8_WAIT_V(n) asm volatile("s_waitcnt vmcnt(" #n ")" ::: "memory")
#define PG8_WAIT_L(n) asm volatile("s_waitcnt lgkmcnt(" #n ")" ::: "memory")
#define PG8_BAR __builtin_amdgcn_s_barrier()
#define PG8_SCHED __builtin_amdgcn_sched_barrier(0)
    Unit cur, nxt; int ui = 0;
    if (!S.next(0, cur)) return;
    f32x4 acc[2][2][4][2];
#pragma unroll
    for (int a = 0; a < 2; ++a)
#pragma unroll
        for (int b = 0; b < 2; ++b)
#pragma unroll
            for (int m = 0; m < 4; ++m)
#pragma unroll
                for (int n = 0; n < 2; ++n) acc[a][b][m][n] = (f32x4){0.f, 0.f, 0.f, 0.f};
    bf16x8 At[4][2], B0[2][2], B1[2][2];
    const char* cA = (const char*)g.A + (size_t)cur.pm * tstep; const char* cB = (const char*)g.Bt + (size_t)cur.pn * tstep;
    S.a_ready(cur);
    if constexpr (SP2) {
        PG8_STAGE(PG8_SB(0, 0), cB, voffB); PG8_STAGE(PG8_SB(0, 1), cB + hstep, voffB); PG8_STAGE(PG8_SA(0, 0), cA, voffA); PG8_STAGE(PG8_SA(0, 1), cA + hstep, voffA);
        if (wr == 1) PG8_BAR;
        PG8_WAIT_V(2); PG8_BAR;
        PG8_STAGE(PG8_SB(1, 0), cB + kstep, voffB); PG8_STAGE(PG8_SA(1, 0), cA + kstep, voffA); PG8_STAGE(PG8_SB(1, 1), cB + hstep + kstep, voffB);
        PG8_WAIT_V(6); PG8_BAR;
    } else {
        PG8_STAGE(PG8_SB(0, 0), cB, voffB); PG8_STAGE(PG8_SA(0, 0), cA, voffA); PG8_STAGE(PG8_SB(0, 1), cB + hstep, voffB); PG8_STAGE(PG8_SA(0, 1), cA + hstep, voffA);
        if (wr == 1) PG8_BAR;
        PG8_WAIT_V(4); PG8_BAR;
        PG8_STAGE(PG8_SB(1, 0), cB + kstep, voffB); PG8_STAGE(PG8_SA(1, 0), cA + kstep, voffA); PG8_STAGE(PG8_SB(1, 1), cB + hstep + kstep, voffB);
        PG8_WAIT_V(6); PG8_BAR;
    }
    for (;;) {
        const bool has_next = S.next(ui + 1, nxt);
        const char* nA = has_next ? (const char*)g.A + (size_t)nxt.pm * tstep : cA; const char* nB = has_next ? (const char*)g.Bt + (size_t)nxt.pn * tstep : cB;
        for (int t = 0; t < nt; t += 2) {
            const bool last = (t == nt - 2);
            const char* a1 = cA + (size_t)(t + 1) * kstep;
            const char* a2 = last ? nA : cA + (size_t)(t + 2) * kstep; const char* b2 = last ? nB : cB + (size_t)(t + 2) * kstep;
            const char* a3 = a2 + kstep; const char* b3 = b2 + kstep;
            if (last && has_next) S.a_ready(nxt);
            if constexpr (SP2) {
            PG8_LDB(B0, 0, 0); PG8_LDB(B1, 0, 1); PG8_SCHED; PG8_LDA(At, 0, 0); PG8_STAGE(PG8_SA(1, 1), a1 + hstep, voffA);
            PG8_WAIT_V(8); PG8_WAIT_L(0); PG8_BAR; PG8_MMA(0, 0, At, B0); PG8_MMA(0, 1, At, B1); PG8_BAR; PG8_SCHED;
            PG8_LDA(At, 0, 1); PG8_STAGE(PG8_SB(0, 0), b2, voffB); PG8_STAGE(PG8_SB(0, 1), b2 + hstep, voffB); PG8_STAGE(PG8_SA(0, 0), a2, voffA);
            PG8_WAIT_V(8); PG8_WAIT_L(0); PG8_BAR; PG8_MMA(1, 0, At, B0); PG8_MMA(1, 1, At, B1); PG8_BAR; PG8_SCHED;
            PG8_LDB(B0, 1, 0); PG8_LDB(B1, 1, 1); PG8_SCHED; PG8_LDA(At, 1, 0); PG8_STAGE(PG8_SA(0, 1), a2 + hstep, voffA);
            PG8_WAIT_V(8); PG8_WAIT_L(0); PG8_BAR; PG8_MMA(0, 0, At, B0); PG8_MMA(0, 1, At, B1); PG8_BAR; PG8_SCHED;
            PG8_LDA(At, 1, 1); PG8_STAGE(PG8_SB(1, 0), b3, voffB); PG8_STAGE(PG8_SB(1, 1), b3 + hstep, voffB); PG8_STAGE(PG8_SA(1, 0), a3, voffA);
            PG8_WAIT_V(8); PG8_WAIT_L(0); PG8_BAR; PG8_MMA(1, 0, At, B0); PG8_MMA(1, 1, At, B1); PG8_BAR; PG8_SCHED;
            } else {
            PG8_LDB(B0, 0, 0); PG8_SCHED; PG8_LDA(At, 0, 0); PG8_STAGE(PG8_SA(1, 1), a1 + hstep, voffA);
            PG8_WAIT_L(8); PG8_BAR; PG8_WAIT_L(0); PG8_MMA(0, 0, At, B0); PG8_BAR; PG8_SCHED;
            PG8_LDB(B1, 0, 1); PG8_STAGE(PG8_SB(0, 0), b2, voffB);
            PG8_BAR; PG8_WAIT_L(0); PG8_MMA(0, 1, At, B1); PG8_BAR;
            PG8_LDA(At, 0, 1); PG8_STAGE(PG8_SA(0, 0), a2, voffA);
            PG8_BAR; PG8_WAIT_L(0); PG8_MMA(1, 0, At, B0); PG8_BAR; PG8_SCHED;
            PG8_STAGE(PG8_SB(0, 1), b2 + hstep, voffB);
            PG8_WAIT_V(6); PG8_BAR; PG8_MMA(1, 1, At, B1); PG8_BAR;
            PG8_LDB(B0, 1, 0); PG8_SCHED; PG8_LDA(At, 1, 0); PG8_STAGE(PG8_SA(0, 1), a2 + hstep, voffA);
            PG8_WAIT_L(8); PG8_BAR; PG8_WAIT_L(0); PG8_MMA(0, 0, At, B0); PG8_BAR; PG8_SCHED;
            PG8_LDB(B1, 1, 1); PG8_STAGE(PG8_SB(1, 0), b3, voffB);
            PG8_BAR; PG8_WAIT_L(0); PG8_MMA(0, 1, At, B1); PG8_BAR;
            PG8_LDA(At, 1, 1); PG8_STAGE(PG8_SA(1, 0), a3, voffA);
            PG8_BAR; PG8_WAIT_L(0); PG8_MMA(1, 0, At, B0); PG8_BAR; PG8_SCHED;
            PG8_STAGE(PG8_SB(1, 1), b3 + hstep, voffB);
            PG8_WAIT_V(6); PG8_BAR; PG8_MMA(1, 1, At, B1); PG8_BAR;
            }
        }
        if constexpr (ALIGN_EPI) { if (wr == 0) PG8_BAR; }
        if constexpr (!Epi::AFTER_DRAIN) { E(acc, cur, wr, wc, fr, fq); S.done(cur); }
        if (!has_next) break;
#pragma unroll
        for (int a = 0; a < 2; ++a)
#pragma unroll
            for (int b = 0; b < 2; ++b)
#pragma unroll
                for (int m = 0; m < 4; ++m)
#pragma unroll
                    for (int n = 0; n < 2; ++n) acc[a][b][m][n] = (f32x4){0.f, 0.f, 0.f, 0.f};
        cur = nxt; cA = nA; cB = nB; ++ui;
        if constexpr (ALIGN_EPI) { if (wr == 1) PG8_BAR; }
    }
    PG8_WAIT_V(0);
    if constexpr (!ALIGN_EPI) { if (wr == 0) PG8_BAR; }
    PG8_BAR;
    if constexpr (Epi::AFTER_DRAIN) { E.fused(acc, cur, wr, wc, fr, fq, lds, wid, lane); S.done(cur); }
#undef PG8_SA
#undef PG8_SB
#undef PG8_STAGE
#undef PG8_LDA
#undef PG8_LDB
#undef PG8_MMA
#undef PG8_WAIT_V
#undef PG8_WAIT_L
#undef PG8_BAR
#undef PG8_SCHED
}
}
namespace mk {
using pg8::f32x4; using pg8::u32x4; using pg8::bf16_t; using pg8::Unit;
typedef float f32x2_t __attribute__((ext_vector_type(2))); typedef __bf16 bf16x2_t __attribute__((ext_vector_type(2)));
__device__ __forceinline__ unsigned cvt_pk_bf16(float lo, float hi) { f32x2_t v = {lo, hi}; bf16x2_t b = __builtin_convertvector(v, bf16x2_t); return __builtin_bit_cast(unsigned, b); }
constexpr int NB = 4, SEQ = 8192, DM = 1024, M = NB * SEQ;
constexpr int DFF = 2816, NFF = 2 * DFF;
constexpr int NIN = 4608;
constexpr int NMOD = 9 * DM;
constexpr int QKVW = 768;
constexpr float EPS = 1e-6f;
constexpr float C2 = 0.125f * 1.4426950408889634f;
constexpr int TPB = SEQ / 256;

__device__ __forceinline__ u32x4 pack8(const f32x4 a, const f32x4 b) {
    u32x4 w; w.x = cvt_pk_bf16(a[0], a[1]); w.y = cvt_pk_bf16(a[2], a[3]); w.z = cvt_pk_bf16(b[0], b[1]); w.w = cvt_pk_bf16(b[2], b[3]); return w;
}
__device__ __forceinline__ float bf_lo(unsigned u) { return __uint_as_float(u << 16); }
__device__ __forceinline__ float bf_hi(unsigned u) { return __uint_as_float(u & 0xffff0000u); }
__device__ __forceinline__ float sigmoid_f(float a) { return __builtin_amdgcn_rcpf(1.0f + __builtin_amdgcn_exp2f(-1.4426950408889634f * a)); }
__device__ __forceinline__ f32x4 sigmoid4(const f32x4 a) { f32x4 r; r[0] = sigmoid_f(a[0]); r[1] = sigmoid_f(a[1]); r[2] = sigmoid_f(a[2]); r[3] = sigmoid_f(a[3]); return r; }
__device__ __forceinline__ float row_rstd(const float* ssq, int row, int fq) {
    const f32x4 v = *(const f32x4*)(ssq + (size_t)row * 16 + 4 * fq);
    float s = (v[0] + v[1]) + (v[2] + v[3]);
    s += __shfl_xor(s, 16); s += __shfl_xor(s, 32);
    return __builtin_amdgcn_rsqf(s * (1.0f / (float)DM) + EPS);
}


template <bool NORM> struct EpiSwiglu {
    static constexpr bool PERM = true, AFTER_DRAIN = false;
    bf16_t* H; const float* ssq; const float* bias;
    __device__ __forceinline__ void operator()(const f32x4 (&acc)[2][2][4][2], const Unit& u, int wr, int wc, int fr, int fq) const {
        const int row0 = u.pm * 256 + wr * 64 + fr, hcol = u.pn * 128 + wc * 32 + 8 * fq;
        f32x4 bv[2][2];
        if (NORM) { const float* bp = bias + (size_t)(u.pm / TPB) * NFF + u.pn * 256 + wc * 32 + 8 * fq;
#pragma unroll
            for (int bj = 0; bj < 2; ++bj)
#pragma unroll
                for (int n = 0; n < 2; ++n) bv[bj][n] = *(const f32x4*)(bp + bj * 128 + 4 * n); }
#pragma unroll
        for (int ai = 0; ai < 2; ++ai)
#pragma unroll
            for (int m = 0; m < 4; ++m) {
                const int row = row0 + ai * 128 + m * 16;
                f32x4 a0 = acc[ai][0][m][0], a1 = acc[ai][0][m][1], b0 = acc[ai][1][m][0], b1 = acc[ai][1][m][1];
                if (NORM) { const float rs = row_rstd(ssq, row, fq); a0 = a0 * rs + bv[0][0]; a1 = a1 * rs + bv[0][1]; b0 = b0 * rs + bv[1][0]; b1 = b1 * rs + bv[1][1]; }
                const f32x4 h0 = a0 * sigmoid4(a0) * b0, h1 = a1 * sigmoid4(a1) * b1;
                *(u32x4*)(H + (size_t)row * DFF + hcol) = pack8(h0, h1);
            }
    }
};

template <bool AOUT, bool HALFG> struct EpiResid {
    static constexpr bool PERM = true, AFTER_DRAIN = false;
    const float* hin; float* hout; const float* gate; bf16_t* A; const float* g; const float* sc; float* ssq;
    __device__ __forceinline__ void operator()(const f32x4 (&acc)[2][2][4][2], const Unit& u, int wr, int wc, int fr, int fq) const {
        const int b = u.pm / TPB, row0 = u.pm * 256 + wr * 64 + fr, col0 = u.pn * 256 + wc * 32 + 8 * fq;
        f32x4 gt[2][2], gs[2][2];
#pragma unroll
        for (int bj = 0; bj < 2; ++bj)
#pragma unroll
            for (int n = 0; n < 2; ++n) { const int c = col0 + bj * 128 + 4 * n;
                gt[bj][n] = *(const f32x4*)(gate + (size_t)b * NMOD + c) * (HALFG ? 0.5f : 1.0f);
                if (AOUT) gs[bj][n] = *(const f32x4*)(g + c) * (*(const f32x4*)(sc + (size_t)b * NMOD + c) + 1.0f); }
#pragma unroll
        for (int ai = 0; ai < 2; ++ai)
#pragma unroll
            for (int m = 0; m < 4; ++m) {
                const int row = row0 + ai * 128 + m * 16; const size_t off = (size_t)row * DM + col0;
                f32x4 hv[2][2]; float q = 0.f;
#pragma unroll
                for (int bj = 0; bj < 2; ++bj)
#pragma unroll
                    for (int n = 0; n < 2; ++n) { const f32x4 r = *(const f32x4*)(hin + off + bj * 128 + 4 * n); const f32x4 h = r + gt[bj][n] * acc[ai][bj][m][n]; hv[bj][n] = h;
                        *(f32x4*)(hout + off + bj * 128 + 4 * n) = h; q += (h[0] * h[0] + h[1] * h[1]) + (h[2] * h[2] + h[3] * h[3]); }
                if (AOUT) {
#pragma unroll
                    for (int bj = 0; bj < 2; ++bj) *(u32x4*)(A + off + bj * 128) = pack8(hv[bj][0] * gs[bj][0], hv[bj][1] * gs[bj][1]); }
                q += __shfl_xor(q, 16); q += __shfl_xor(q, 32);
                if (fq == 0) ssq[(size_t)row * 16 + 4 * u.pn + wc] = q;
                if (m & 1) asm volatile("" ::: "memory");
            }
    }
};

struct EpiInProj {
    static constexpr bool PERM = true, AFTER_DRAIN = false;
    const float* ssq; const float* bias; const float* cs; float* PP; bf16_t* Q; bf16_t* K; bf16_t* V; bf16_t* G;
    __device__ __forceinline__ void operator()(const f32x4 (&acc)[2][2][4][2], const Unit& u, int wr, int wc, int fr, int fq) const {
        const int row0 = u.pm * 256 + wr * 64 + fr, pn = u.pn;
        f32x4 bv[2][2];
        { const float* bp = bias + (size_t)(u.pm / TPB) * NIN + pn * 256 + wc * 32 + 8 * fq;
#pragma unroll
            for (int bj = 0; bj < 2; ++bj)
#pragma unroll
                for (int n = 0; n < 2; ++n) bv[bj][n] = *(const f32x4*)(bp + bj * 128 + 4 * n); }
        if (pn == 0) {
#pragma unroll
            for (int ai = 0; ai < 2; ++ai)
#pragma unroll
                for (int m = 0; m < 4; ++m) { const int row = row0 + ai * 128 + m * 16; const float rs = row_rstd(ssq, row, fq);
                    float* dst = PP + (size_t)row * 256 + wc * 32 + 8 * fq;
#pragma unroll
                    for (int bj = 0; bj < 2; ++bj)
#pragma unroll
                        for (int n = 0; n < 2; ++n) *(f32x4*)(dst + bj * 128 + 4 * n) = acc[ai][bj][m][n] * rs + bv[bj][n]; }
        } else if (pn <= 6) {
            const bool isq = pn <= 3; const int head = 4 * (isq ? pn - 1 : pn - 4) + wc; const float osc = isq ? C2 : 1.0f;
            bf16_t* base = (isq ? Q : K) + head * 64 + 8 * fq;
#pragma unroll
            for (int ai = 0; ai < 2; ++ai)
#pragma unroll
                for (int m = 0; m < 4; ++m) { const int row = row0 + ai * 128 + m * 16; const float rs = row_rstd(ssq, row, fq) ;
                    const float* cp = cs + (size_t)row * 64 + 8 * fq;
                    f32x4 o1[2], o2[2];
#pragma unroll
                    for (int n = 0; n < 2; ++n) { const f32x4 c = *(const f32x4*)(cp + 4 * n) * osc, s = *(const f32x4*)(cp + 32 + 4 * n) * osc;
                        const f32x4 x1 = acc[ai][0][m][n] * rs + bv[0][n], x2 = acc[ai][1][m][n] * rs + bv[1][n];
                        o1[n] = x1 * c - x2 * s; o2[n] = x2 * c + x1 * s; }
                    bf16_t* dst = base + (size_t)row * QKVW;
                    *(u32x4*)dst = pack8(o1[0], o1[1]); *(u32x4*)(dst + 32) = pack8(o2[0], o2[1]); }
        } else if (pn <= 9) {
            bf16_t* base = V + (pn - 7) * 256 + wc * 32 + 8 * fq;
#pragma unroll
            for (int ai = 0; ai < 2; ++ai)
#pragma unroll
                for (int m = 0; m < 4; ++m) { const int row = row0 + ai * 128 + m * 16; const float rs = row_rstd(ssq, row, fq);
                    bf16_t* dst = base + (size_t)row * QKVW;
#pragma unroll
                    for (int bj = 0; bj < 2; ++bj) *(u32x4*)(dst + bj * 128) = pack8(acc[ai][bj][m][0] * rs + bv[bj][0], acc[ai][bj][m][1] * rs + bv[bj][1]); }
        } else {
            bf16_t* base = G + (pn - 10) * 256 + wc * 32 + 8 * fq;
#pragma unroll
            for (int ai = 0; ai < 2; ++ai)
#pragma unroll
                for (int m = 0; m < 4; ++m) { const int row = row0 + ai * 128 + m * 16; const float rs = row_rstd(ssq, row, fq);
                    bf16_t* dst = base + (size_t)row * 2048;
#pragma unroll
                    for (int bj = 0; bj < 2; ++bj) *(u32x4*)(dst + bj * 128) = pack8(sigmoid4(acc[ai][bj][m][0] * rs + bv[bj][0]), sigmoid4(acc[ai][bj][m][1] * rs + bv[bj][1])); }
        }
    }
};

struct EpiMerge {
    static constexpr bool PERM = true, AFTER_DRAIN = false;
    const bf16_t* G; bf16_t* Y;
    __device__ __forceinline__ void operator()(const f32x4 (&acc)[2][2][4][2], const Unit& u, int wr, int wc, int fr, int fq) const {
        const int row0 = u.pm * 256 + wr * 64 + fr, c = u.pn * 128 + wc * 32 + 8 * fq;
#pragma unroll
        for (int ai = 0; ai < 2; ++ai)
#pragma unroll
            for (int m = 0; m < 4; ++m) { const int row = row0 + ai * 128 + m * 16;
                const u32x4 gp = *(const u32x4*)(G + (size_t)row * 2048 + c), ga = *(const u32x4*)(G + (size_t)row * 2048 + 1024 + c);
                const f32x4 p0 = {bf_lo(gp.x), bf_hi(gp.x), bf_lo(gp.y), bf_hi(gp.y)}, p1 = {bf_lo(gp.z), bf_hi(gp.z), bf_lo(gp.w), bf_hi(gp.w)};
                const f32x4 a0 = {bf_lo(ga.x), bf_hi(ga.x), bf_lo(ga.y), bf_hi(ga.y)}, a1 = {bf_lo(ga.z), bf_hi(ga.z), bf_lo(ga.w), bf_hi(ga.w)};
                const f32x4 y0 = p0 * acc[ai][0][m][0] + a0 * acc[ai][1][m][0], y1 = p1 * acc[ai][0][m][1] + a1 * acc[ai][1][m][1];
                *(u32x4*)(Y + (size_t)row * DM + c) = pack8(y0, y1); }
    }
};
}

namespace at {
typedef short bf16x8 __attribute__((ext_vector_type(8)));
typedef float f32x16 __attribute__((ext_vector_type(16)));
typedef short v4i16_t __attribute__((ext_vector_type(4)));
typedef __attribute__((address_space(3))) unsigned char* lds_ptr;
constexpr int SEQ = 8192, PITCH = 768;
constexpr float NEG = -INFINITY;

__device__ __forceinline__ unsigned cvt2(float lo, float hi) { typedef float f2 __attribute__((ext_vector_type(2))); typedef __bf16 b2 __attribute__((ext_vector_type(2))); f2 v = {lo, hi}; b2 b = __builtin_convertvector(v, b2); return __builtin_bit_cast(unsigned, b); }

__device__ __forceinline__ void dma_v(const unsigned short* Vh, long rowbase, int dsh, int i0, int kt, lds_ptr slot, int lane) {
#pragma unroll
    for (int u = 0; u < 4; ++u) { int idx = i0 - 128 + 32 * kt + 8 * u + (lane >> 3); idx = idx < 0 ? 0 : idx;
        const unsigned short* src = Vh + (rowbase + ((long)idx << dsh)) * PITCH + 8 * (lane & 7);
        __builtin_amdgcn_global_load_lds((const unsigned*)src, (__attribute__((address_space(3))) unsigned*)(slot + u * 1024), 16, 0, 0); }
}

__device__ __forceinline__ void task(const unsigned short* Qh, const unsigned short* Kh, const unsigned short* Vh, long rowbase, int dsh, int i0,
                                     unsigned short* OGh  , float* LSj  , lds_ptr vlds, int lane) {
    const int q = lane & 31, hh = lane >> 5;
    const int ninv = i0 < 128 ? (128 - i0) >> 5 : 0;
    dma_v(Vh, rowbase, dsh, i0, 0, vlds, lane); dma_v(Vh, rowbase, dsh, i0, 1, vlds + 4096, lane); dma_v(Vh, rowbase, dsh, i0, 2, vlds + 8192, lane); dma_v(Vh, rowbase, dsh, i0, 3, vlds + 12288, lane);
    const long qrow = rowbase + ((long)(i0 + q) << dsh);
    bf16x8 qf[4];
#pragma unroll
    for (int s = 0; s < 4; ++s) qf[s] = *(const bf16x8*)(Qh + qrow * PITCH + 16 * s + 8 * hh);
    f32x16 S[5];
#pragma unroll
    for (int kt = 0; kt < 5; ++kt) { int idx = i0 - 128 + 32 * kt + q; idx = idx < 0 ? 0 : idx;
        const unsigned short* kp = Kh + (rowbase + ((long)idx << dsh)) * PITCH + 8 * hh;
        bf16x8 kf[4];
#pragma unroll
        for (int s = 0; s < 4; ++s) kf[s] = *(const bf16x8*)(kp + 16 * s);
        f32x16 acc = {};
#pragma unroll
        for (int s = 0; s < 4; ++s) acc = __builtin_amdgcn_mfma_f32_32x32x16_bf16(kf[s], qf[s], acc, 0, 0, 0);
        S[kt] = acc; }
    float mx = NEG;
#pragma unroll
    for (int kt = 0; kt < 5; ++kt) {
#pragma unroll
        for (int i = 0; i < 16; ++i) { const int kr = (i & 3) + 8 * (i >> 2) + 4 * hh; bool ok = kt >= ninv;
            if (kt == 0) ok = ok && (kr >= q);
            if (kt == 4) ok = ok && (kr <= q);
            const float v = ok ? S[kt][i] : NEG; S[kt][i] = v; mx = fmaxf(mx, v); } }
    mx = fmaxf(mx, __shfl_xor(mx, 32));
    float l = 0.f;
#pragma unroll
    for (int kt = 0; kt < 5; ++kt)
#pragma unroll
        for (int i = 0; i < 16; ++i) { const float p = __builtin_amdgcn_exp2f(S[kt][i] - mx); S[kt][i] = p; l += p; }
    l += __shfl_xor(l, 32);
    f32x16 O0 = {}, O1 = {};
    const int g4 = lane >> 4, li = lane & 15;
    const int trbase = (4 * (g4 >> 1) + (li >> 2)) * 128 + (16 * (g4 & 1) + 4 * (li & 3)) * 2;
    asm volatile("s_waitcnt vmcnt(0)" ::: "memory");
#define AT_PV(kt, slot) do { _Pragma("unroll") for (int s2 = 0; s2 < 2; ++s2) { \
        union { bf16x8 v; unsigned u[4]; } pf; pf.u[0] = cvt2(S[kt][8 * s2 + 0], S[kt][8 * s2 + 1]); pf.u[1] = cvt2(S[kt][8 * s2 + 2], S[kt][8 * s2 + 3]); pf.u[2] = cvt2(S[kt][8 * s2 + 4], S[kt][8 * s2 + 5]); pf.u[3] = cvt2(S[kt][8 * s2 + 6], S[kt][8 * s2 + 7]); \
        _Pragma("unroll") for (int db = 0; db < 2; ++db) { \
            const lds_ptr p0 = vlds + (slot) * 4096 + trbase + s2 * 16 * 128 + db * 64; \
            const v4i16_t lo = __builtin_amdgcn_ds_read_tr16_b64_v4i16((__attribute__((address_space(3))) v4i16_t*)p0); \
            const v4i16_t hi = __builtin_amdgcn_ds_read_tr16_b64_v4i16((__attribute__((address_space(3))) v4i16_t*)(p0 + 8 * 128)); \
            const bf16x8 vf = {lo[0], lo[1], lo[2], lo[3], hi[0], hi[1], hi[2], hi[3]}; \
            if (db == 0) O0 = __builtin_amdgcn_mfma_f32_32x32x16_bf16(vf, pf.v, O0, 0, 0, 0); else O1 = __builtin_amdgcn_mfma_f32_32x32x16_bf16(vf, pf.v, O1, 0, 0, 0); } } } while (0)
    AT_PV(0, 0);
    asm volatile("s_waitcnt lgkmcnt(0)" ::: "memory");
    dma_v(Vh, rowbase, dsh, i0, 4, vlds, lane);
    AT_PV(1, 1); AT_PV(2, 2); AT_PV(3, 3);
    asm volatile("s_waitcnt vmcnt(0)" ::: "memory");
    AT_PV(4, 0);
#undef AT_PV
    asm volatile("s_waitcnt lgkmcnt(0)" ::: "memory");
    const float rl = 1.0f / l;
    unsigned short* orow = OGh + qrow * 256;
#pragma unroll
    for (int db = 0; db < 2; ++db)
#pragma unroll
        for (int gq = 0; gq < 4; ++gq) { const f32x16& O = db == 0 ? O0 : O1;
            const unsigned long long w = (unsigned long long)cvt2(O[4 * gq] * rl, O[4 * gq + 1] * rl) | ((unsigned long long)cvt2(O[4 * gq + 2] * rl, O[4 * gq + 3] * rl) << 32);
            *(unsigned long long*)(orow + 32 * db + 8 * gq + 4 * hh) = w; }
    if (hh == 0) LSj[qrow * 4] = mx + __log2f(l);
}
}
constexpr int NWAVES = 8;
#ifdef MK_PROBE
constexpr int NPH = 14;
#else
constexpr int NPH = 11;
#endif
#ifndef MK_N_LAUNCHES
#define MK_N_LAUNCHES 1
#endif
constexpr int N_LAUNCHES = MK_N_LAUNCHES;
static_assert(N_LAUNCHES == 1 || N_LAUNCHES == NPH, "MK_N_LAUNCHES is 1 or NPH");

using mk::NB; using mk::SEQ; using mk::DM; using mk::M; using mk::DFF; using mk::NFF; using mk::NIN; using mk::NMOD; using mk::QKVW;

constexpr size_t MiB = 1u << 20;
constexpr size_t WS_CTL = 0, CTL_ZERO_BYTES = 1 * MiB;
constexpr size_t WS_MOD = 1 * MiB;
constexpr size_t WS_BIAS2 = 1 * MiB + 256 * 1024;
constexpr size_t WS_BIAS3 = 1 * MiB + 512 * 1024;
constexpr size_t WS_SSQ2 = 2 * MiB, WS_SSQ3 = 4 * MiB, WS_SSQF = 6 * MiB;
constexpr size_t WS_CS = 8 * MiB;
constexpr size_t WS_W1IN = 16 * MiB, WS_W1OUT = 27 * MiB, WS_WIN = 33 * MiB, WS_WM = 42 * MiB, WS_WOUT = 44 * MiB, WS_W2IN = 46 * MiB, WS_W2OUT = 57 * MiB;
constexpr size_t WS_XA = 64 * MiB;
constexpr size_t WS_YA = 128 * MiB;
constexpr size_t WS_PP = 160 * MiB;
constexpr size_t WS_Q = 192 * MiB, WS_K = 240 * MiB, WS_V = 288 * MiB;
constexpr size_t WS_G = 336 * MiB;
constexpr size_t WS_MERGED = 192 * MiB;
constexpr size_t WS_HID = 192 * MiB;
constexpr size_t WS_END = 464 * MiB;
static_assert(WS_W1IN + (size_t)NFF * DM * 2 <= WS_W1OUT && WS_W1OUT + (size_t)DM * DFF * 2 <= WS_WIN && WS_WIN + (size_t)NIN * DM * 2 <= WS_WM && WS_WM + (size_t)2048 * 512 * 2 <= WS_WOUT &&
              WS_WOUT + (size_t)DM * DM * 2 <= WS_W2IN && WS_W2IN + (size_t)NFF * DM * 2 <= WS_W2OUT && WS_W2OUT + (size_t)DM * DFF * 2 <= WS_XA, "weight map");
static_assert(WS_HID + (size_t)M * DFF * 2 <= WS_END && WS_G + (size_t)M * 2048 * 2 <= WS_END && WS_MERGED + (size_t)M * DM * 2 <= WS_V, "activation map");
constexpr int CW_BAR = 4096;

constexpr int RING_OFF = 0, RING_BYTES = 131072;
constexpr int LDSCTL_OFF = RING_BYTES, MISC_OFF = LDSCTL_OFF + 320;
constexpr int LDS_BYTES = 147456;
static_assert(MISC_OFF + 128 <= LDS_BYTES, "LDS map");

#define GAS __attribute__((address_space(1)))
#define LAS __attribute__((address_space(3)))
typedef unsigned short bf16;
typedef unsigned v4u __attribute__((ext_vector_type(4)));
typedef float f32x4 __attribute__((ext_vector_type(4)));
typedef short bf16x8 __attribute__((ext_vector_type(8)));
typedef GAS unsigned gu32;
typedef GAS unsigned long long gu64;
#define RLX_AGENT __ATOMIC_RELAXED, __HIP_MEMORY_SCOPE_AGENT
#define LDS_WAIT() asm volatile("s_waitcnt lgkmcnt(0)" ::: "memory")
#define VM_WAIT() asm volatile("s_waitcnt vmcnt(0)" ::: "memory")
__device__ __forceinline__ unsigned long long rt() { return __builtin_amdgcn_s_memrealtime(); }
__device__ __forceinline__ unsigned f2bf(float f) { unsigned u = __builtin_bit_cast(unsigned, f); return (u + 0x7fffu + ((u >> 16) & 1u)) >> 16; }
__device__ __forceinline__ unsigned pk2(float lo, float hi) { return f2bf(lo) | (f2bf(hi) << 16); }

#define XB_TMO      128
#define XB_XCNT(j)  (256  + 64 * (j))
#define XB_XSUB(j)  (1280 + 64 * (j))
#define XB_XGEN(j)  (2304 + 64 * (j))
#define XB_TOP      3328
#define XB_TOPGEN   3392
#define XCD_BAR_WORDS 3456
#define XB_SPIN_CAP (1u << 18)

__device__ __forceinline__ unsigned xb_ld(unsigned* p)              { return __hip_atomic_load(p, __ATOMIC_RELAXED, __HIP_MEMORY_SCOPE_AGENT); }
__device__ __forceinline__ unsigned xb_add(unsigned* p, unsigned v) { return __hip_atomic_fetch_add(p, v, __ATOMIC_RELAXED, __HIP_MEMORY_SCOPE_AGENT); }
__device__ __forceinline__ unsigned xb_xcc_id() { return (unsigned)__builtin_amdgcn_s_getreg((3 << 11) | 20) & 0xFu; }
#define XB_SPIN(cond, bar) do { unsigned _sp = 0; while (cond) { __builtin_amdgcn_s_sleep(1); \
    if ((++_sp & 255u) == 0u) { if (xb_ld(&(bar)[XB_TMO])) break; if (_sp > XB_SPIN_CAP) { atomicAdd(&(bar)[XB_TMO], 1u); break; } } } } while (0)

struct XcdBarrier {
    unsigned* bar; unsigned x;
    volatile LAS unsigned* st;
};

__device__ __forceinline__ XcdBarrier xcd_barrier_post(unsigned* bar, volatile LAS unsigned* st) {
    XcdBarrier b; b.bar = bar; b.x = xb_xcc_id(); b.st = st;
    if (threadIdx.x == 0) (void)xb_add(&bar[XB_XCNT(b.x)], 1u);
    return b;
}
__device__ __forceinline__ void xcd_barrier_complete(unsigned* bar, unsigned x, unsigned& nloc, unsigned& nx) {
    const unsigned G = gridDim.x * gridDim.y * gridDim.z;
    unsigned sum, cnt, mine, sp = 0u;
    for (;;) {
        sum = 0u; cnt = 0u; mine = 0u;
#pragma unroll
        for (unsigned j = 0; j < 16; ++j) { const unsigned c = xb_ld(&bar[XB_XCNT(j)]); sum += c; cnt += (c > 0u) ? 1u : 0u; mine = (j == x) ? c : mine; }
        if (sum == G) break;
        __builtin_amdgcn_s_sleep(1);
        if ((++sp & 255u) == 0u) { if (xb_ld(&bar[XB_TMO])) break; if (sp > XB_SPIN_CAP) { atomicAdd(&bar[XB_TMO], 1u); break; } }
    }
    nloc = mine > 0u ? mine : 1u; nx = cnt > 0u ? cnt : 1u;
}

__device__ __forceinline__ void xcd_barrier(const XcdBarrier& b) {
    asm volatile("s_waitcnt vmcnt(0)" ::: "memory");
    __syncthreads();
    if (threadIdx.x == 0) {
        unsigned* bar = b.bar;
        __builtin_amdgcn_s_waitcnt(0);
        unsigned nloc = b.st[0], nx = b.st[1];
        if (nloc == 0u) { xcd_barrier_complete(bar, b.x, nloc, nx); b.st[0] = nloc; b.st[1] = nx; }
        const unsigned old = xb_add(&bar[XB_XSUB(b.x)], 1u);
        const unsigned gen = old / nloc;
        if (old + 1u == (gen + 1u) * nloc) {
            __builtin_amdgcn_fence(__ATOMIC_RELEASE, "agent");
            asm volatile("s_waitcnt vmcnt(0)" ::: "memory");
            const unsigned og = xb_add(&bar[XB_TOP], 1u);
            const unsigned tg = og / nx;
            if (og + 1u == (tg + 1u) * nx) xb_add(&bar[XB_TOPGEN], 1u);
            else XB_SPIN(xb_ld(&bar[XB_TOPGEN]) == tg, bar);
            __builtin_amdgcn_fence(__ATOMIC_ACQUIRE, "agent");
            xb_add(&bar[XB_XGEN(b.x)], 1u);
            asm volatile("s_waitcnt vmcnt(0)" ::: "memory");
        } else {
            XB_SPIN(xb_ld(&bar[XB_XGEN(b.x)]) == gen, bar);
            __builtin_amdgcn_fence(__ATOMIC_ACQUIRE, "agent");
            asm volatile("s_waitcnt vmcnt(0)" ::: "memory");
        }
    }
    __syncthreads();
}

struct Frame {
    LAS unsigned char* lds;
    volatile LAS unsigned* MISC;
    gu32* ctl;
    int tid, lane, wave;
    int vcu, G;
};
__device__ __forceinline__ float wave_sum(float v) {
#pragma unroll
    for (int o = 1; o < 64; o <<= 1) v += __shfl_xor(v, o);
    return v;
}
__device__ __forceinline__ float wave_max(float v) {
#pragma unroll
    for (int o = 1; o < 64; o <<= 1) v = fmaxf(v, __shfl_xor(v, o));
    return v;
}
__device__ __forceinline__ float silu_f(float a) { return a * mk::sigmoid_f(a); }

__device__ __forceinline__ void tr_item(const float* W, int N, int k0, int n0, bf16* WT, int Kd, int dst_row0, int dst_k0, LAS float* scr, int lane) {
#pragma unroll 8
    for (int i = 0; i < 32; ++i) { const int kk = 2 * i + (lane >> 5); scr[kk * 33 + (lane & 31)] = W[(size_t)(k0 + kk) * N + n0 + (lane & 31)]; }
    LDS_WAIT(); asm volatile("" ::: "memory");
    const int c = lane & 7;
#pragma unroll
    for (int j = 0; j < 4; ++j) { const int n = (lane >> 3) + 8 * j; const LAS float* s = scr + (8 * c) * 33 + n;
        v4u o; o.x = pk2(s[0 * 33], s[1 * 33]); o.y = pk2(s[2 * 33], s[3 * 33]); o.z = pk2(s[4 * 33], s[5 * 33]); o.w = pk2(s[6 * 33], s[7 * 33]);
        *(v4u*)(WT + (size_t)(dst_row0 + n) * Kd + dst_k0 + 8 * c) = o; }
    LDS_WAIT(); asm volatile("" ::: "memory");
}
__device__ __forceinline__ void zero_item(bf16* WT, int Kd, int dst_row0, int dst_k0, int lane) {
    const int c = lane & 7;
#pragma unroll
    for (int j = 0; j < 4; ++j) { const int n = (lane >> 3) + 8 * j; *(v4u*)(WT + (size_t)(dst_row0 + n) * Kd + dst_k0 + 8 * c) = (v4u){0u, 0u, 0u, 0u}; }
}
__device__ __forceinline__ int ffn_row0(int n0) { const int half = n0 >= DFF ? 1 : 0, j = n0 - half * DFF; return 256 * (j >> 7) + 128 * half + (j & 127); }
__device__ __forceinline__ int inproj_row0(int n0) {
    if (n0 < 1024) { const int e = n0 - 256, head = e >> 6, bj = (e >> 5) & 1; return 256 * (1 + (head >> 2)) + 128 * bj + 32 * (head & 3); }
    if (n0 < 1792) { const int e = n0 - 1024, head = e >> 6, bj = (e >> 5) & 1; return 256 * (4 + (head >> 2)) + 128 * bj + 32 * (head & 3); }
    return n0;
}

struct Ptrs {
    const float *x, *c; const int* pos; const float *w_ada, *b_ada, *g1, *w1in, *w1out, *g2, *w_in, *w_pool, *pool_scale, *w_pb, *w_ab, *w_out, *g3, *w2in, *w2out, *gf;
    float* out; unsigned char* ws;
};

__constant__ float INV_FREQ[32] = {
    1.0f, 0.74989420933f, 0.56234132519f, 0.42169650343f, 0.31622776602f, 0.23713737057f, 0.17782794100f, 0.13335214322f,
    0.1f, 0.074989420933f, 0.056234132519f, 0.042169650343f, 0.031622776602f, 0.023713737057f, 0.017782794100f, 0.013335214322f,
    0.01f, 0.0074989420933f, 0.0056234132519f, 0.0042169650343f, 0.0031622776602f, 0.0023713737057f, 0.0017782794100f, 0.0013335214322f,
    0.001f, 0.00074989420933f, 0.00056234132519f, 0.00042169650343f, 0.00031622776602f, 0.00023713737057f, 0.00017782794100f, 0.00013335214322f };

__device__ __forceinline__ void p0_prologue(Frame& F, const Ptrs& P) {
    unsigned char* ws = P.ws;
    float* mod = (float*)(ws + WS_MOD);
    {
        LAS float* cond = (LAS float*)(F.lds + RING_OFF);
        LAS float* red = (LAS float*)(F.lds + RING_OFF + 16384);
        for (int i = F.tid; i < NB * DM; i += NWAVES * 64) { const int b = i >> 10, k = i & 1023; cond[k * 4 + b] = silu_f(P.c[i]); }
        __syncthreads();
        for (int item = F.vcu; item < NMOD / 64; item += F.G) {
            const int n = item * 64 + F.lane; float a0 = 0.f, a1 = 0.f, a2 = 0.f, a3 = 0.f;
            const float* wp = P.w_ada + (size_t)(F.wave * 128) * NMOD + n;
#pragma unroll 8
            for (int k = 0; k < 128; ++k) { const float w = wp[(size_t)k * NMOD]; const LAS float* cp = cond + (F.wave * 128 + k) * 4; a0 += cp[0] * w; a1 += cp[1] * w; a2 += cp[2] * w; a3 += cp[3] * w; }
            red[(F.wave * 4 + 0) * 64 + F.lane] = a0; red[(F.wave * 4 + 1) * 64 + F.lane] = a1; red[(F.wave * 4 + 2) * 64 + F.lane] = a2; red[(F.wave * 4 + 3) * 64 + F.lane] = a3;
            __syncthreads();
            if (F.wave < 4) { float s = P.b_ada[n];
#pragma unroll
                for (int w = 0; w < 8; ++w) s += red[(w * 4 + F.wave) * 64 + F.lane];
                mod[(size_t)F.wave * NMOD + n] = s; }
            __syncthreads();
        }
    }
    LAS float* scr = (LAS float*)(F.lds + RING_OFF + F.wave * 16384);
    const int gw = F.vcu * NWAVES + F.wave, NGW = F.G * NWAVES;
    constexpr int I_FIN = (DM / 64) * (NFF / 32);
    constexpr int I_FOUT = (DFF / 64) * (DM / 32);
    constexpr int I_IN = (DM / 64) * ((NIN - 256) / 32);
    constexpr int I_BR = (256 / 64) * (DM / 32);
    constexpr int I_OUT = (DM / 64) * (DM / 32);
    constexpr int I_POOL = (DM / 64) * (256 / 32);
    constexpr int I_CS = M / 64;
    constexpr int NITEMS = 2 * I_FIN + 2 * I_FOUT + I_IN + 2 * I_BR + I_OUT + I_POOL + I_CS;
    bf16* W1IN = (bf16*)(ws + WS_W1IN); bf16* W1OUT = (bf16*)(ws + WS_W1OUT); bf16* WIN = (bf16*)(ws + WS_WIN); bf16* WM = (bf16*)(ws + WS_WM);
    bf16* WOUT = (bf16*)(ws + WS_WOUT); bf16* W2IN = (bf16*)(ws + WS_W2IN); bf16* W2OUT = (bf16*)(ws + WS_W2OUT);
    for (int it = gw; it < NITEMS; it += NGW) {
        int r = it;
        if (r < 2 * I_FIN) { const bool second = r >= I_FIN; if (second) r -= I_FIN; const int nblk = NFF / 32, kb = r / nblk, nb = r % nblk;
            tr_item(second ? P.w2in : P.w1in, NFF, 64 * kb, 32 * nb, second ? W2IN : W1IN, DM, ffn_row0(32 * nb), 64 * kb, scr, F.lane); continue; }
        r -= 2 * I_FIN;
        if (r < 2 * I_FOUT) { const bool second = r >= I_FOUT; if (second) r -= I_FOUT; const int nblk = DM / 32, kb = r / nblk, nb = r % nblk;
            tr_item(second ? P.w2out : P.w1out, DM, 64 * kb, 32 * nb, second ? W2OUT : W1OUT, DFF, 32 * nb, 64 * kb, scr, F.lane); continue; }
        r -= 2 * I_FOUT;
        if (r < I_IN) { const int nblk = (NIN - 256) / 32, kb = r / nblk, nb = r % nblk, n0 = 256 + 32 * nb;
            tr_item(P.w_in, NIN, 64 * kb, n0, WIN, DM, inproj_row0(n0), 64 * kb, scr, F.lane); continue; }
        r -= I_IN;
        if (r < 2 * I_BR) { const bool attn = r >= I_BR; if (attn) r -= I_BR; const int nblk = DM / 32, kb = r / nblk, nb = r % nblk, n0 = 32 * nb;
            const int row0 = 256 * (n0 >> 7) + (attn ? 128 : 0) + (n0 & 127);
            tr_item(attn ? P.w_ab : P.w_pb, DM, 64 * kb, n0, WM, 512, row0, (attn ? 256 : 0) + 64 * kb, scr, F.lane);
            zero_item(WM, 512, row0, (attn ? 0 : 256) + 64 * kb, F.lane); continue; }
        r -= 2 * I_BR;
        if (r < I_OUT) { const int nblk = DM / 32, kb = r / nblk, nb = r % nblk;
            tr_item(P.w_out, DM, 64 * kb, 32 * nb, WOUT, DM, 32 * nb, 64 * kb, scr, F.lane); continue; }
        r -= I_OUT;
        if (r < I_POOL) {
            const int kb = r / 8, nb = r % 8, g = nb >> 1, dd0 = (nb & 1) * 32, k = 64 * kb + F.lane;
            const float* wr = P.w_in + (size_t)k * NIN + 64 * g; const float* wp = P.w_pool + (size_t)g * 4096 + dd0;
            float o[32];
#pragma unroll
            for (int d = 0; d < 32; ++d) o[d] = 0.f;
            for (int c4 = 0; c4 < 16; ++c4) { const f32x4 a = *(const f32x4*)(wr + 4 * c4);
#pragma unroll
                for (int ci = 0; ci < 4; ++ci) { const float av = a[ci]; const float* wq = wp + (size_t)(4 * c4 + ci) * 64;
#pragma unroll
                    for (int d = 0; d < 32; ++d) o[d] += av * wq[d]; } }
#pragma unroll
            for (int d = 0; d < 32; ++d) { const int np = 32 * nb + d; WIN[(size_t)np * DM + k] = (bf16)f2bf(o[d] * P.pool_scale[np]); }
            continue; }
        r -= I_POOL;
        {
            const int f = F.lane & 31; const float invf = INV_FREQ[f];
            float* cs = (float*)(ws + WS_CS);
            for (int i = 0; i < 32; ++i) { const int m = 64 * r + 2 * i + (F.lane >> 5);
                const float ang = (float)P.pos[m] * invf;
                const double a = (double)ang; const double kq = rint(a * 0.15915494309189535); const double red = fma(-kq, 6.283185307179586, a) - kq * 2.4492935982947064e-16;
                const float rr = (float)red;
                cs[(size_t)m * 64 + f] = cosf(rr); cs[(size_t)m * 64 + 32 + f] = sinf(rr); }
        }
    }
}

__device__ __forceinline__ void p1_prologue(Frame& F, const Ptrs& P) {
    unsigned char* ws = P.ws; const float* mod = (const float*)(ws + WS_MOD);
    const int gw = F.vcu * NWAVES + F.wave, NGW = F.G * NWAVES;
    bf16* XA = (bf16*)(ws + WS_XA);
    for (int m = gw; m < M; m += NGW) {
        const int b = m / SEQ; const f32x4* xr = (const f32x4*)(P.x + (size_t)m * DM) + F.lane;
        f32x4 v[4]; float s = 0.f;
#pragma unroll
        for (int j = 0; j < 4; ++j) { v[j] = xr[64 * j]; s += (v[j].x * v[j].x + v[j].y * v[j].y) + (v[j].z * v[j].z + v[j].w * v[j].w); }
        const float rstd = __builtin_amdgcn_rsqf(wave_sum(s) * (1.f / DM) + mk::EPS);
        unsigned long long* o8 = (unsigned long long*)(XA + (size_t)m * DM) + F.lane;
#pragma unroll
        for (int j = 0; j < 4; ++j) { const int c = 4 * F.lane + 256 * j;
            const f32x4 g = *(const f32x4*)(P.g1 + c), sh = *(const f32x4*)(mod + (size_t)b * NMOD + c), sc = *(const f32x4*)(mod + (size_t)b * NMOD + DM + c);
            const f32x4 y = (v[j] * rstd * g) * (sc + 1.0f) + sh;
            o8[64 * j] = (unsigned long long)pk2(y.x, y.y) | ((unsigned long long)pk2(y.z, y.w) << 32); }
    }
    for (int it = gw; it < NIN + NFF; it += NGW) {
        const bool second = it >= NIN; const int n = second ? it - NIN : it;
        const bf16* wrow = (const bf16*)(ws + (second ? WS_W2IN : WS_WIN)) + (size_t)n * DM + 16 * F.lane;
        const v4u w0 = *(const v4u*)wrow, w1 = *(const v4u*)(wrow + 8);
        float wv[16] = { mk::bf_lo(w0.x), mk::bf_hi(w0.x), mk::bf_lo(w0.y), mk::bf_hi(w0.y), mk::bf_lo(w0.z), mk::bf_hi(w0.z), mk::bf_lo(w0.w), mk::bf_hi(w0.w),
                         mk::bf_lo(w1.x), mk::bf_hi(w1.x), mk::bf_lo(w1.y), mk::bf_hi(w1.y), mk::bf_lo(w1.z), mk::bf_hi(w1.z), mk::bf_lo(w1.w), mk::bf_hi(w1.w) };
        float* dst = (float*)(ws + (second ? WS_BIAS3 : WS_BIAS2));
        const int shoff = (second ? 6 : 3) * DM;
#pragma unroll
        for (int b = 0; b < NB; ++b) { const float* sh = mod + (size_t)b * NMOD + shoff + 16 * F.lane; float s = 0.f;
#pragma unroll
            for (int q = 0; q < 4; ++q) { const f32x4 t = *(const f32x4*)(sh + 4 * q); s += (t.x * wv[4 * q] + t.y * wv[4 * q + 1]) + (t.z * wv[4 * q + 2] + t.w * wv[4 * q + 3]); }
            s = wave_sum(s);
            if (F.lane == 0) dst[(size_t)b * (second ? NFF : NIN) + n] = s; }
    }
}

constexpr size_t WS_OG = WS_XA;
constexpr size_t WS_LS = WS_SSQ3;
static_assert(3 * (size_t)M * 256 * 2 <= 64 * MiB && 3 * (size_t)M * 4 * 4 <= 2 * MiB, "attention scratch fits its hosts");
__device__ __forceinline__ void p5_mixers(Frame& F, const Ptrs& P) {
    unsigned char* ws = P.ws;
    const float* PP = (const float*)(ws + WS_PP); bf16* YA = (bf16*)(ws + WS_YA);
    const bf16* Q = (const bf16*)(ws + WS_Q); const bf16* K = (const bf16*)(ws + WS_K); const bf16* V = (const bf16*)(ws + WS_V);
    bf16* OG = (bf16*)(ws + WS_OG); float* LS = (float*)(ws + WS_LS);
    const int gw = F.vcu * NWAVES + F.wave, NGW = F.G * NWAVES;
    for (int u = F.vcu; u < 256; u += F.G) {
        const int b = u >> 6, j = (u >> 4) & 3, beta = u & 15;
        for (int tau = F.wave; tau < 48; tau += NWAVES) {
            const int g = tau >> 4, x = tau & 15, dsh = 2 * g, h = 4 * g + j;
            const int r = g == 0 ? 0 : (g == 1 ? (x >> 2) : x);
            const int i0 = g == 0 ? 512 * beta + 32 * x : (g == 1 ? 128 * beta + 32 * (x & 3) : 32 * beta);
            at::task(Q + h * 64, K + h * 64, V + h * 64, (long)b * SEQ + r, dsh, i0, OG + (size_t)g * M * 256 + j * 64, LS + (size_t)g * M * 4 + j,
                     (at::lds_ptr)(F.lds + RING_OFF + F.wave * 16384), F.lane);
        }
        asm volatile("s_waitcnt vmcnt(0)" ::: "memory");
        __syncthreads();
        __builtin_amdgcn_fence(__ATOMIC_ACQUIRE, "agent");
        asm volatile("s_waitcnt vmcnt(0)" ::: "memory");
        for (int it = 0; it < 8; ++it) {
            const size_t row = (size_t)b * SEQ + 512 * beta + 64 * it + (F.tid >> 3); const int ch = F.tid & 7;
            float ls[3]; v4u ov[3];
#pragma unroll
            for (int g = 0; g < 3; ++g) { ls[g] = LS[((size_t)g * M + row) * 4 + j]; ov[g] = *(const v4u*)(OG + ((size_t)g * M + row) * 256 + j * 64 + 8 * ch); }
            const float mx = fmaxf(fmaxf(ls[0], ls[1]), ls[2]);
            const float e0 = __builtin_amdgcn_exp2f(ls[0] - mx), e1 = __builtin_amdgcn_exp2f(ls[1] - mx), e2 = __builtin_amdgcn_exp2f(ls[2] - mx), rs = 1.0f / (e0 + e1 + e2);
            const float w0 = e0 * rs, w1 = e1 * rs, w2 = e2 * rs;
            v4u o;
#define JOIN(c) { const float lo = w0 * mk::bf_lo(ov[0].c) + w1 * mk::bf_lo(ov[1].c) + w2 * mk::bf_lo(ov[2].c), hi = w0 * mk::bf_hi(ov[0].c) + w1 * mk::bf_hi(ov[1].c) + w2 * mk::bf_hi(ov[2].c); o.c = pk2(lo, hi); }
            JOIN(x) JOIN(y) JOIN(z) JOIN(w)
#undef JOIN
            *(v4u*)(YA + row * 512 + 256 + j * 64 + 8 * ch) = o;
        }
        __syncthreads();
    }
    for (int c = gw; c < M / 16; c += NGW) {
        const int R0 = 16 * c, t0 = R0 % SEQ, w = 2 << (F.lane >> 4);
        const float* p = PP + (size_t)R0 * 256 + 4 * F.lane;
        f32x4 s = {0.f, 0.f, 0.f, 0.f};
        for (int jj = 1; jj < w; ++jj) if (t0 - jj >= 0) s += *(const f32x4*)(p - (size_t)jj * 256);
#pragma unroll 4
        for (int k = 0; k < 16; ++k) { const int t = t0 + k; const f32x4 cur = *(const f32x4*)(p + (size_t)k * 256); s += cur;
            const int cnt = (t + 1 < w) ? t + 1 : w;
            const f32x4 y = s * (1.0f / (float)cnt) - cur;
            *(unsigned long long*)(YA + (size_t)(R0 + k) * 512 + 4 * F.lane) = (unsigned long long)pk2(y.x, y.y) | ((unsigned long long)pk2(y.z, y.w) << 32);
            if (t + 1 - w >= 0) s -= *(const f32x4*)(p + (size_t)(k + 1 - w) * 256); }
    }
}

__device__ __forceinline__ void p10_final_norm(Frame& F, const Ptrs& P) {
    const int gw = F.vcu * NWAVES + F.wave, NGW = F.G * NWAVES;
    for (int m = gw; m < M; m += NGW) {
        f32x4* xr = (f32x4*)(P.out + (size_t)m * DM) + F.lane;
        f32x4 v[4]; float s = 0.f;
#pragma unroll
        for (int j = 0; j < 4; ++j) { v[j] = xr[64 * j]; s += (v[j].x * v[j].x + v[j].y * v[j].y) + (v[j].z * v[j].z + v[j].w * v[j].w); }
        const float rstd = __builtin_amdgcn_rsqf(wave_sum(s) * (1.f / DM) + mk::EPS);
#pragma unroll
        for (int j = 0; j < 4; ++j) { const f32x4 g = *(const f32x4*)(P.gf + 4 * F.lane + 256 * j); xr[64 * j] = v[j] * rstd * g; }
    }
}


#ifdef MK_PROBE
constexpr int CW_DBG = 32768;
__device__ __forceinline__ void probe_rows(Frame& F, const float* h, const float* ssq, int slot) {
    const int gw = F.vcu * NWAVES + F.wave, NGW = F.G * NWAVES;
    for (int m = gw; m < M; m += NGW) {
        const f32x4* xr = (const f32x4*)(h + (size_t)m * DM) + F.lane; float s = 0.f;
#pragma unroll
        for (int j = 0; j < 4; ++j) { const f32x4 v = xr[64 * j]; s += (v.x * v.x + v.y * v.y) + (v.z * v.z + v.w * v.w); }
        s = wave_sum(s);
        float t = 0.f; if (ssq) { t = (F.lane < 16) ? ssq[(size_t)m * 16 + F.lane] : 0.f; t = wave_sum(t); }
        if (F.lane == 0) { if (!(s * (1.f / DM) <= 9.0f)) atomicAdd((unsigned*)(F.ctl + CW_DBG + slot), 1u);
            if (ssq && !(fabsf(t - s) <= 1e-3f * s)) atomicAdd((unsigned*)(F.ctl + CW_DBG + slot + 1), 1u); }
    }
}

__device__ __forceinline__ void probe_corr(Frame& F, const float* a, const float* b, const bf16* ab, int slot) {
    const int gw = F.vcu * NWAVES + F.wave, NGW = F.G * NWAVES;
    for (int m = gw; m < M; m += NGW) {
        float sxx = 0.f, soo = 0.f, sxo = 0.f;
#pragma unroll
        for (int j = 0; j < 4; ++j) { const int c = 4 * F.lane + 256 * j; const f32x4 y = *(const f32x4*)(b + (size_t)m * DM + c); f32x4 x;
            if (ab) { const unsigned long long w = *(const unsigned long long*)(ab + (size_t)m * DM + c); x = (f32x4){mk::bf_lo((unsigned)w), mk::bf_hi((unsigned)w), mk::bf_lo((unsigned)(w >> 32)), mk::bf_hi((unsigned)(w >> 32))}; }
            else x = *(const f32x4*)(a + (size_t)m * DM + c);
            sxx += x.x * x.x + x.y * x.y + x.z * x.z + x.w * x.w; soo += y.x * y.x + y.y * y.y + y.z * y.z + y.w * y.w; sxo += x.x * y.x + x.y * y.y + x.z * y.z + x.w * y.w; }
        sxx = wave_sum(sxx); soo = wave_sum(soo); sxo = wave_sum(sxo);
        if (F.lane == 0 && !(sxo > 0.8f * sqrtf(sxx * soo))) { atomicAdd((unsigned*)(F.ctl + CW_DBG + 16 + slot), 1u); if ((m & 2047) == 1601) atomicAdd((unsigned*)(F.ctl + CW_DBG + 16 + 8 + slot), 1u); }
    }
}

__device__ __forceinline__ void probe_mag(Frame& F, const float* a, const bf16* ab, int pitch, int c0, float lim, int slot) {
    const int gw = F.vcu * NWAVES + F.wave, NGW = F.G * NWAVES;
    for (int m = gw; m < M; m += NGW) {
        f32x4 x;
        if (ab) { const unsigned long long w = *(const unsigned long long*)(ab + (size_t)m * pitch + c0 + 4 * F.lane); x = (f32x4){mk::bf_lo((unsigned)w), mk::bf_hi((unsigned)w), mk::bf_lo((unsigned)(w >> 32)), mk::bf_hi((unsigned)(w >> 32))}; }
        else x = *(const f32x4*)(a + (size_t)m * pitch + c0 + 4 * F.lane);
        const float s = wave_sum(x.x * x.x + x.y * x.y + x.z * x.z + x.w * x.w);
        if (F.lane == 0 && !(s * (1.f / 256.f) <= lim)) { atomicAdd((unsigned*)(F.ctl + CW_DBG + 16 + slot), 1u); if ((m & 2047) == 1601) atomicAdd((unsigned*)(F.ctl + CW_DBG + 16 + 8 + slot), 1u); }
    }
}

__device__ __forceinline__ void probe_max(Frame& F, const bf16* ab, int pitch, int c0, int ncols, int slot) {
    const int gw = F.vcu * NWAVES + F.wave, NGW = F.G * NWAVES; float mx = 0.f;
    for (int m = gw; m < M; m += NGW) for (int c = 4 * F.lane; c < ncols; c += 256) {
        const unsigned long long w = *(const unsigned long long*)(ab + (size_t)m * pitch + c0 + c);
        mx = fmaxf(mx, fmaxf(fmaxf(fabsf(mk::bf_lo((unsigned)w)), fabsf(mk::bf_hi((unsigned)w))), fmaxf(fabsf(mk::bf_lo((unsigned)(w >> 32))), fabsf(mk::bf_hi((unsigned)(w >> 32)))))); }
    mx = wave_max(mx); if (F.lane == 0) atomicMax((unsigned*)(F.ctl + CW_DBG + 32 + slot), __float_as_uint(mx));
}

__device__ __forceinline__ void probe_gcount(Frame& F, const bf16* ab, int slot) {
    const int gw = F.vcu * NWAVES + F.wave, NGW = F.G * NWAVES;
    for (int m = gw; m < M; m += NGW) { unsigned n = 0;
        for (int c = 4 * F.lane; c < 2048; c += 256) {
            const unsigned long long w = *(const unsigned long long*)(ab + (size_t)m * 2048 + c);
            const float v0 = mk::bf_lo((unsigned)w), v1 = mk::bf_hi((unsigned)w), v2 = mk::bf_lo((unsigned)(w >> 32)), v3 = mk::bf_hi((unsigned)(w >> 32));
            n += (!(v0 >= 0.f && v0 <= 1.01f)) + (!(v1 >= 0.f && v1 <= 1.01f)) + (!(v2 >= 0.f && v2 <= 1.01f)) + (!(v3 >= 0.f && v3 <= 1.01f)); }
        if (n) atomicAdd((unsigned*)(F.ctl + CW_DBG + 48 + slot + (m >= 8192 ? 1 : 0)), n); }
}

__device__ __forceinline__ void probe_gtile(Frame& F, const bf16* ab) {
    const int gw = F.vcu * NWAVES + F.wave, NGW = F.G * NWAVES;
    for (int m = gw; m < M; m += NGW) {
        for (int ct = 0; ct < 8; ++ct) {
            const unsigned long long w = *(const unsigned long long*)(ab + (size_t)m * 2048 + ct * 256 + 4 * F.lane);
            const float v0 = mk::bf_lo((unsigned)w), v1 = mk::bf_hi((unsigned)w), v2 = mk::bf_lo((unsigned)(w >> 32)), v3 = mk::bf_hi((unsigned)(w >> 32));
            const int n = (!(v0 >= 0.f && v0 <= 1.01f)) + (!(v1 >= 0.f && v1 <= 1.01f)) + (!(v2 >= 0.f && v2 <= 1.01f)) + (!(v3 >= 0.f && v3 <= 1.01f));
            if (__any(n != 0) && F.lane == 0) { const unsigned idx = (unsigned)((m >> 8) * 8 + ct); atomicMax((unsigned*)(F.ctl + CW_DBG + 56), idx + 1u); atomicMax((unsigned*)(F.ctl + CW_DBG + 57), 4096u - idx); atomicAdd((unsigned*)(F.ctl + CW_DBG + 58), 1u); if (idx != 0u && idx != 1023u) atomicMax((unsigned*)(F.ctl + CW_DBG + 59), idx + 1u); } } }
}
#endif

struct Args { Ptrs p; int ph_lo, ph_hi, li, pad; };
__global__ void __launch_bounds__(NWAVES * 64, 2) mk_fwd(Args args) {
    extern __shared__ __attribute__((aligned(16))) unsigned char lds[];
    Frame F;
    F.lds = (LAS unsigned char*)lds;
    F.MISC = (volatile LAS unsigned*)(F.lds + MISC_OFF);
    F.tid = threadIdx.x; F.lane = F.tid & 63; F.wave = __builtin_amdgcn_readfirstlane(F.tid >> 6);
    F.G = gridDim.x; { const int bx = blockIdx.x; F.vcu = (F.G % 8 == 0) ? (bx % 8) * (F.G / 8) + bx / 8 : bx; }
    const Ptrs& P = args.p;
    unsigned char* ws = P.ws;
    F.ctl = (gu32*)(ws + WS_CTL);
    for (int u = F.tid; u < (LDS_BYTES - LDSCTL_OFF) / 4; u += NWAVES * 64) ((LAS unsigned*)(F.lds + LDSCTL_OFF))[u] = 0u;
    __syncthreads();
    XcdBarrier bar; bar.bar = (unsigned*)(F.ctl + CW_BAR); bar.x = 0; bar.st = nullptr;
    if (N_LAUNCHES == 1) bar = xcd_barrier_post((unsigned*)(F.ctl + CW_BAR), F.MISC + 8);
#define GRID_BAR() do { if (N_LAUNCHES == 1) xcd_barrier(bar); } while (0)
    const int lo = args.ph_lo, hi = args.ph_hi;
#define IN(k) (lo <= (k) && (k) < hi)
#define BOTH(k) (IN(k) && IN((k) + 1))
    float* mod = (float*)(ws + WS_MOD);
    bf16* XA = (bf16*)(ws + WS_XA); bf16* HID = (bf16*)(ws + WS_HID);
    float* SSQ2 = (float*)(ws + WS_SSQ2); float* SSQ3 = (float*)(ws + WS_SSQ3); float* SSQF = (float*)(ws + WS_SSQF);

    if (IN(0)) { p0_prologue(F, P); if (BOTH(0)) GRID_BAR(); }
    if (IN(1)) { p1_prologue(F, P); if (BOTH(1)) GRID_BAR(); }
#ifdef MK_PROBE
#endif
    if (IN(2)) {
        pg8::Gemm g{XA, (const bf16*)(ws + WS_W1IN), M, NFF, DM}; pg8::StaticOrder S; S.init(M, NFF, F.G, (int)blockIdx.x);
        mk::EpiSwiglu<false> E{HID, nullptr, nullptr};
        pg8::gemm_phase<mk::EpiSwiglu<false>, pg8::StaticOrder, true, true>(F.lds + RING_OFF, g, S, E);
        if (BOTH(2)) GRID_BAR();
    }
    if (IN(3)) {
        pg8::Gemm g{HID, (const bf16*)(ws + WS_W1OUT), M, DM, DFF}; pg8::StaticOrder S; S.init(M, DM, F.G, (int)blockIdx.x);
        mk::EpiResid<true, true> E{P.x, P.out, mod + 2 * DM, XA, P.g2, mod + 4 * DM, SSQ2};
        pg8::gemm_phase<mk::EpiResid<true, true>, pg8::StaticOrder, true, true>(F.lds + RING_OFF, g, S, E);
        if (BOTH(3)) GRID_BAR();
    }
    if (IN(4)) {
#ifdef MK_PROBE
#endif
        pg8::Gemm g{XA, (const bf16*)(ws + WS_WIN), M, NIN, DM}; pg8::StaticOrder S; S.init(M, NIN, F.G, (int)blockIdx.x);
        mk::EpiInProj E{SSQ2, (const float*)(ws + WS_BIAS2), (const float*)(ws + WS_CS), (float*)(ws + WS_PP), (bf16*)(ws + WS_Q), (bf16*)(ws + WS_K), (bf16*)(ws + WS_V), (bf16*)(ws + WS_G)};
        pg8::gemm_phase<mk::EpiInProj, pg8::StaticOrder, true, true>(F.lds + RING_OFF, g, S, E);
        if (BOTH(4)) GRID_BAR();
    }
#ifdef MK_PROBE
#endif
    if (IN(5)) { p5_mixers(F, P); if (BOTH(5)) GRID_BAR(); }
#ifdef MK_PROBE
    if (IN(5)) probe_gtile(F, (const bf16*)(ws + WS_G));
    if (0) { probe_max(F, (const bf16*)(ws + WS_G), 2048, 0, 2048, 0); probe_max(F, (const bf16*)(ws + WS_YA), 512, 0, 256, 1); probe_max(F, (const bf16*)(ws + WS_YA), 512, 256, 256, 2); probe_max(F, (const bf16*)(ws + WS_MERGED), 1024, 0, 1024, 3); }
#endif
    if (IN(6)) {
        pg8::Gemm g{(const bf16*)(ws + WS_YA), (const bf16*)(ws + WS_WM), M, 2048, 512}; pg8::StaticOrder S; S.init(M, 2048, F.G, (int)blockIdx.x);
        mk::EpiMerge E{(const bf16*)(ws + WS_G), (bf16*)(ws + WS_MERGED)};
        pg8::gemm_phase<mk::EpiMerge, pg8::StaticOrder, true, true>(F.lds + RING_OFF, g, S, E);
        if (BOTH(6)) GRID_BAR();
    }
    if (IN(7)) {
        pg8::Gemm g{(const bf16*)(ws + WS_MERGED), (const bf16*)(ws + WS_WOUT), M, DM, DM}; pg8::StaticOrder S; S.init(M, DM, F.G, (int)blockIdx.x);
        mk::EpiResid<true, false> E{P.out, P.out, mod + 5 * DM, XA, P.g3, mod + 7 * DM, SSQ3};
        pg8::gemm_phase<mk::EpiResid<true, false>, pg8::StaticOrder, true, true>(F.lds + RING_OFF, g, S, E);
        if (BOTH(7)) GRID_BAR();
    }
    if (IN(8)) {
#ifdef MK_PROBE
#endif
        pg8::Gemm g{XA, (const bf16*)(ws + WS_W2IN), M, NFF, DM}; pg8::StaticOrder S; S.init(M, NFF, F.G, (int)blockIdx.x);
        mk::EpiSwiglu<true> E{HID, SSQ3, (const float*)(ws + WS_BIAS3)};
        pg8::gemm_phase<mk::EpiSwiglu<true>, pg8::StaticOrder, true, true>(F.lds + RING_OFF, g, S, E);
        if (BOTH(8)) GRID_BAR();
    }
    if (IN(9)) {
        pg8::Gemm g{HID, (const bf16*)(ws + WS_W2OUT), M, DM, DFF}; pg8::StaticOrder S; S.init(M, DM, F.G, (int)blockIdx.x);
        mk::EpiResid<false, true> E{P.out, P.out, mod + 8 * DM, nullptr, nullptr, nullptr, SSQF};
        pg8::gemm_phase<mk::EpiResid<false, true>, pg8::StaticOrder, true, true>(F.lds + RING_OFF, g, S, E);
        if (BOTH(9)) GRID_BAR();
    }
#ifdef MK_PROBE
    if (IN(10)) { }
    if (IN(11)) { p10_final_norm(F, P); }
    if (IN(12)) {
        const int gw = F.vcu * NWAVES + F.wave, NGW = F.G * NWAVES;
        for (int m = gw; m < M; m += NGW) {
            const f32x4* xr = (const f32x4*)(P.x + (size_t)m * DM) + F.lane; const f32x4* orow = (const f32x4*)(P.out + (size_t)m * DM) + F.lane; float sxx = 0.f, soo = 0.f, sxo = 0.f;
#pragma unroll
            for (int j = 0; j < 4; ++j) { const f32x4 a = xr[64 * j], b = orow[64 * j]; sxx += a.x * a.x + a.y * a.y + a.z * a.z + a.w * a.w; soo += b.x * b.x + b.y * b.y + b.z * b.z + b.w * b.w; sxo += a.x * b.x + a.y * b.y + a.z * b.z + a.w * b.w; }
            sxx = wave_sum(sxx); soo = wave_sum(soo); sxo = wave_sum(sxo);
            if (F.lane == 0 && !(sxo > 0.8f * sqrtf(sxx * soo))) { atomicAdd((unsigned*)(F.ctl + CW_DBG + 16 + 6), 1u); }
        }
    }
    if (IN(13)) { if (blockIdx.x == 0 && F.tid == 0) {
        const unsigned nseg = __hip_atomic_load(F.ctl + CW_DBG + 58, RLX_AGENT), oth = __hip_atomic_load(F.ctl + CW_DBG + 59, RLX_AGENT);
        if (MK_PROBE == 1) { if (nseg) P.out[0] = 1e6f * (float)nseg; }
        else if (oth) { const unsigned sel = oth - 1u; P.out[0] = __builtin_powf(10.f, 4.0f + (float)(sel >> 5)) * (1.0f + 0.25f * (float)(sel & 31u)); } } }
#else
    if (IN(10)) { p10_final_norm(F, P); }
#endif
#undef IN
#undef BOTH
#undef GRID_BAR
}

extern "C" void kernel_launch(void* const* d_in, const int* in_sizes, int n_in, void* d_out, int out_size, void* d_ws, size_t ws_size, hipStream_t stream) {
    static int grid = 0;
    if (grid == 0) {
        if (n_in != 19 || in_sizes[0] != M * DM || out_size != M * DM || ws_size < WS_END) { fprintf(stderr, "kernel_launch: unexpected shapes (n_in %d, in0 %d, out %d, ws %zu); nothing launched\n", n_in, n_in > 0 ? in_sizes[0] : -1, out_size, ws_size); grid = -1; return; }
        int dev = 0, cus = 0, per_cu = 0;
        if (hipGetDevice(&dev) != hipSuccess || hipDeviceGetAttribute(&cus, hipDeviceAttributeMultiprocessorCount, dev) != hipSuccess) { fprintf(stderr, "kernel_launch: device query failed\n"); grid = -1; return; }
        if (hipFuncSetAttribute((const void*)mk_fwd, hipFuncAttributeMaxDynamicSharedMemorySize, LDS_BYTES) != hipSuccess) { fprintf(stderr, "kernel_launch: hipFuncSetAttribute failed\n"); grid = -1; return; }
        if (hipOccupancyMaxActiveBlocksPerMultiprocessor(&per_cu, (const void*)mk_fwd, NWAVES * 64, LDS_BYTES) != hipSuccess || per_cu < 1)
            fprintf(stderr, "kernel_launch: note: occupancy query reports %d workgroups per CU\n", per_cu);
        (void)hipGetLastError();
        grid = cus;
    }
    if (grid < 0) return;
    if (hipMemsetAsync((char*)d_ws + WS_CTL, 0, CTL_ZERO_BYTES, stream) != hipSuccess) { fprintf(stderr, "kernel_launch: memset failed\n"); return; }
    Args a{};
    a.p.x = (const float*)d_in[0]; a.p.c = (const float*)d_in[1]; a.p.pos = (const int*)d_in[2]; a.p.w_ada = (const float*)d_in[3]; a.p.b_ada = (const float*)d_in[4];
    a.p.g1 = (const float*)d_in[5]; a.p.w1in = (const float*)d_in[6]; a.p.w1out = (const float*)d_in[7]; a.p.g2 = (const float*)d_in[8]; a.p.w_in = (const float*)d_in[9];
    a.p.w_pool = (const float*)d_in[10]; a.p.pool_scale = (const float*)d_in[11]; a.p.w_pb = (const float*)d_in[12]; a.p.w_ab = (const float*)d_in[13]; a.p.w_out = (const float*)d_in[14];
    a.p.g3 = (const float*)d_in[15]; a.p.w2in = (const float*)d_in[16]; a.p.w2out = (const float*)d_in[17]; a.p.gf = (const float*)d_in[18];
    a.p.out = (float*)d_out; a.p.ws = (unsigned char*)d_ws;
    for (int li = 0; li < N_LAUNCHES; ++li) {
        a.ph_lo = (N_LAUNCHES == 1) ? 0 : li; a.ph_hi = (N_LAUNCHES == 1) ? NPH : li + 1; a.li = li;
        hipLaunchKernelGGL(mk_fwd, dim3(grid), dim3(NWAVES * 64), LDS_BYTES, stream, a);
        const hipError_t le = hipPeekAtLastError();
        if (le != hipSuccess) { fprintf(stderr, "kernel_launch: launch %d failed: %s\n", li, hipGetErrorName(le)); break; }
    }
}
```

```cpp
#include <hip/hip_runtime.h>
#include <cstdio>
#include <cstdint>
#define MK_N_LAUNCHES 1
namespace pg8 {
#define PG8_LAS __attribute__((address_space(3)))
typedef unsigned short bf16_t;
typedef short bf16x8 __attribute__((ext_vector_type(8)));
typedef float f32x4 __attribute__((ext_vector_type(4)));
typedef unsigned u32x4 __attribute__((ext_vector_type(4)));
constexpr int BM = 256, BK = 64, HALF = 128, HTB = HALF * BK * 2  , STAGE_BYTES = 8 * HTB, NXCD = 8, WGM = 8;

__host__ __device__ __forceinline__ int lds_byte(int r, int c) { const int st = (r >> 4) * 2 + (c >> 5), rr = r & 15, cc = c & 31, ob = rr * 64 + cc * 2; return st * 1024 + (ob ^ (((ob >> 9) & 1) << 5)); }
__host__ __device__ __forceinline__ void stage_rc(int b, int& R, int& C) { const int st = b / 1024, sb = b % 1024, swz = sb ^ (((sb >> 9) & 1) << 5); R = (st >> 1) * 16 + swz / 64; C = (st & 1) * 32 + (swz % 64) / 2; }
__host__ __device__ __forceinline__ int perm32(int rho) { const int n = rho >> 4, i = rho & 15; return 8 * (i >> 2) + 4 * n + (i & 3); }

struct Unit { int pm, pn; };
struct Gemm { const bf16_t* A; const bf16_t* Bt; int M, N, K; };

struct StaticOrder {
    int nM, nN, nwg, G, c;
    __host__ __device__ void init(int M, int N, int G_, int c_) { nM = M / BM; nN = N / BM; nwg = nM * nN; G = G_; c = c_; }
    __host__ __device__ bool next(int i, Unit& u) const {
        const long L = (long)i * G + c; if (L >= nwg) return false;
        int wgid = (int)L; { const int q = nwg / NXCD, r = nwg % NXCD, xcd = wgid % NXCD, off = wgid / NXCD; wgid = (xcd < r ? xcd * (q + 1) : r * (q + 1) + (xcd - r) * q) + off; }
        const int nig = WGM * nN, gid = wgid / nig, fm = gid * WGM, gsz = (nM - fm) < WGM ? (nM - fm) : WGM;
        u.pm = fm + ((wgid % nig) % gsz); u.pn = (wgid % nig) / gsz; return true;
    }
    __device__ __forceinline__ void a_ready(const Unit&) const {}
    __device__ __forceinline__ void done(const Unit&) const {}
};

__device__ __forceinline__ unsigned cvt_pk_bf16(float lo, float hi) { unsigned r; asm volatile("v_cvt_pk_bf16_f32 %0, %1, %2" : "=v"(r) : "v"(lo), "v"(hi)); return r; }
template <class Epi, class Sched, bool ALIGN_EPI = false, bool SP2 = false>
__device__ __forceinline__ void gemm_phase(PG8_LAS unsigned char* lds, const Gemm g, const Sched& S, const Epi& E) {
    const int tid = threadIdx.x, wid = __builtin_amdgcn_readfirstlane(tid >> 6), lane = tid & 63, wr = wid >> 2, wc = wid & 3, fr = lane & 15, fq = lane >> 4;
    const int K = g.K, nt = K / BK;
    unsigned voffA[2], voffB[2];
#pragma unroll
    for (int i = 0; i < 2; ++i) { int R, C; stage_rc(tid * 16 + i * 8192, R, C); const int Rb = Epi::PERM ? ((R & ~31) + perm32(R & 31)) : R;
        voffA[i] = (unsigned)(R * K + C) * 2u; voffB[i] = (unsigned)(Rb * K + C) * 2u; }
    const size_t kstep = (size_t)(BK * 2);
    const size_t hstep = (size_t)HALF * K * 2;
    const size_t tstep = 2 * hstep;
    const unsigned ldsw = (unsigned)wid * 1024u;
    const int aoff = lds_byte(wr * 64 + fr, fq * 8), boff = lds_byte(wc * 32 + fr, fq * 8);
#define PG8_SA(b, h) (((b) * 2 + (h)) * HTB)
#define PG8_SB(b, h) ((4 + (b) * 2 + (h)) * HTB)
#define PG8_STAGE(bufoff, gbase, voff) do { _Pragma("unroll") for (int _i = 0; _i < 2; ++_i) \
        __builtin_amdgcn_global_load_lds((const unsigned*)((const char*)(gbase) + (voff)[_i]), (PG8_LAS unsigned*)(lds + (bufoff) + ldsw + _i * 8192), 16, 0, 0); } while (0)
#define PG8_LDA(dst, b, h) do { _Pragma("unroll") for (int m = 0; m < 4; ++m) _Pragma("unroll") for (int k = 0; k < 2; ++k) dst[m][k] = *(const PG8_LAS bf16x8*)(lds + PG8_SA(b, h) + aoff + m * 2048 + k * 1024); } while (0)
#define PG8_LDB(dst, b, h) do { _Pragma("unroll") for (int n = 0; n < 2; ++n) _Pragma("unroll") for (int k = 0; k < 2; ++k) dst[n][k] = *(const PG8_LAS bf16x8*)(lds + PG8_SB(b, h) + boff + n * 2048 + k * 1024); } while (0)
#define PG8_MMA(ai, bj, At, Bt) do { __builtin_amdgcn_s_setprio(1); _Pragma("unroll") for (int m = 0; m < 4; ++m) _Pragma("unroll") for (int n = 0; n < 2; ++n) _Pragma("unroll") for (int k = 0; k < 2; ++k) \
        acc[ai][bj][m][n] = __builtin_amdgcn_mfma_f32_16x16x32_bf16(Bt[n][k], At[m][k], acc[ai][bj][m][n], 0, 0, 0); __builtin_amdgcn_s_setprio(0); } while (0)
#define PG8_WAIT_V(n) asm volatile("s_waitcnt vmcnt(" #n ")" ::: "memory")
#define PG8_WAIT_L(n) asm volatile("s_waitcnt lgkmcnt(" #n ")" ::: "memory")
#define PG8_BAR __builtin_amdgcn_s_barrier()
#define PG8_SCHED __builtin_amdgcn_sched_barrier(0)
    Unit cur, nxt; int ui = 0;
    if (!S.next(0, cur)) return;
    f32x4 acc[2][2][4][2];
#pragma unroll
    for (int a = 0; a < 2; ++a)
#pragma unroll
        for (int b = 0; b < 2; ++b)
#pragma unroll
            for (int m = 0; m < 4; ++m)
#pragma unroll
                for (int n = 0; n < 2; ++n) acc[a][b][m][n] = (f32x4){0.f, 0.f, 0.f, 0.f};
    bf16x8 At[4][2], B0[2][2], B1[2][2];
    const char* cA = (const char*)g.A + (size_t)cur.pm * tstep; const char* cB = (const char*)g.Bt + (size_t)cur.pn * tstep;
    S.a_ready(cur);
    if constexpr (SP2) {
        PG8_STAGE(PG8_SB(0, 0), cB, voffB); PG8_STAGE(PG8_SB(0, 1), cB + hstep, voffB); PG8_STAGE(PG8_SA(0, 0), cA, voffA); PG8_STAGE(PG8_SA(0, 1), cA + hstep, voffA);
        if (wr == 1) PG8_BAR;
        PG8_WAIT_V(2); PG8_BAR;
        PG8_STAGE(PG8_SB(1, 0), cB + kstep, voffB); PG8_STAGE(PG8_SA(1, 0), cA + kstep, voffA); PG8_STAGE(PG8_SB(1, 1), cB + hstep + kstep, voffB);
        PG8_WAIT_V(6); PG8_BAR;
    } else {
        PG8_STAGE(PG8_SB(0, 0), cB, voffB); PG8_STAGE(PG8_SA(0, 0), cA, voffA); PG8_STAGE(PG8_SB(0, 1), cB + hstep, voffB); PG8_STAGE(PG8_SA(0, 1), cA + hstep, voffA);
        if (wr == 1) PG8_BAR;
        PG8_WAIT_V(4); PG8_BAR;
        PG8_STAGE(PG8_SB(1, 0), cB + kstep, voffB); PG8_STAGE(PG8_SA(1, 0), cA + kstep, voffA); PG8_STAGE(PG8_SB(1, 1), cB + hstep + kstep, voffB);
        PG8_WAIT_V(6); PG8_BAR;
    }
    for (;;) {
        const bool has_next = S.next(ui + 1, nxt);
        const char* nA = has_next ? (const char*)g.A + (size_t)nxt.pm * tstep : cA; const char* nB = has_next ? (const char*)g.Bt + (size_t)nxt.pn * tstep : cB;
        for (int t = 0; t < nt; t += 2) {
            const bool last = (t == nt - 2);
            const char* a1 = cA + (size_t)(t + 1) * kstep;
            const char* a2 = last ? nA : cA + (size_t)(t + 2) * kstep; const char* b2 = last ? nB : cB + (size_t)(t + 2) * kstep;
            const char* a3 = a2 + kstep; const char* b3 = b2 + kstep;
            if (last && has_next) S.a_ready(nxt);
            if constexpr (SP2) {
            PG8_LDB(B0, 0, 0); PG8_LDB(B1, 0, 1); PG8_SCHED; PG8_LDA(At, 0, 0); PG8_STAGE(PG8_SA(1, 1), a1 + hstep, voffA);
            PG8_WAIT_V(8); PG8_WAIT_L(0); PG8_BAR; PG8_MMA(0, 0, At, B0); PG8_MMA(0, 1, At, B1); PG8_BAR; PG8_SCHED;
            PG8_LDA(At, 0, 1); PG8_STAGE(PG8_SB(0, 0), b2, voffB); PG8_STAGE(PG8_SB(0, 1), b2 + hstep, voffB); PG8_STAGE(PG8_SA(0, 0), a2, voffA);
            PG8_WAIT_V(8); PG8_WAIT_L(0); PG8_BAR; PG8_MMA(1, 0, At, B0); PG8_MMA(1, 1, At, B1); PG8_BAR; PG8_SCHED;
            PG8_LDB(B0, 1, 0); PG8_LDB(B1, 1, 1); PG8_SCHED; PG8_LDA(At, 1, 0); PG8_STAGE(PG8_SA(0, 1), a2 + hstep, voffA);
            PG8_WAIT_V(8); PG8_WAIT_L(0); PG8_BAR; PG8_MMA(0, 0, At, B0); PG8_MMA(0, 1, At, B1); PG8_BAR; PG8_SCHED;
            PG8_LDA(At, 1, 1); PG8_STAGE(PG8_SB(1, 0), b3, voffB); PG8_STAGE(PG8_SB(1, 1), b3 + hstep, voffB); PG8_STAGE(PG8_SA(1, 0), a3, voffA);
            PG8_WAIT_V(8); PG8_WAIT_L(0); PG8_BAR; PG8_MMA(1, 0, At, B0); PG8_MMA(1, 1, At, B1); PG8_BAR; PG8_SCHED;
            } else {
            PG8_LDB(B0, 0, 0); PG8_SCHED; PG8_LDA(At, 0, 0); PG8_STAGE(PG8_SA(1, 1), a1 + hstep, voffA);
            PG8_WAIT_L(8); PG8_BAR; PG8_WAIT_L(0); PG8_MMA(0, 0, At, B0); PG8_BAR; PG8_SCHED;
            PG8_LDB(B1, 0, 1); PG8_STAGE(PG8_SB(0, 0), b2, voffB);
            PG8_BAR; PG8_WAIT_L(0); PG8_MMA(0, 1, At, B1); PG8_BAR;
            PG8_LDA(At, 0, 1); PG8_STAGE(PG8_SA(0, 0), a2, voffA);
            PG8_BAR; PG8_WAIT_L(0); PG8_MMA(1, 0, At, B0); PG8_BAR; PG8_SCHED;
            PG8_STAGE(PG8_SB(0, 1), b2 + hstep, voffB);
            PG8_WAIT_V(6); PG8_BAR; PG8_MMA(1, 1, At, B1); PG8_BAR;
            PG8_LDB(B0, 1, 0); PG8_SCHED; PG8_LDA(At, 1, 0); PG8_STAGE(PG8_SA(0, 1), a2 + hstep, voffA);
            PG8_WAIT_L(8); PG8_BAR; PG8_WAIT_L(0); PG8_MMA(0, 0, At, B0); PG8_BAR; PG8_SCHED;
            PG8_LDB(B1, 1, 1); PG8_STAGE(PG8_SB(1, 0), b3, voffB);
            PG8_BAR; PG8_WAIT_L(0); PG8_MMA(0, 1, At, B1); PG8_BAR;
            PG8_LDA(At, 1, 1); PG8_STAGE(PG8_SA(1, 0), a3, voffA);
            PG8_BAR; PG8_WAIT_L(0); PG8_MMA(1, 0, At, B0); PG8_BAR; PG8_SCHED;
            PG8_STAGE(PG8_SB(1, 1), b3 + hstep, voffB);
            PG8_WAIT_V(6); PG8_BAR; PG8_MMA(1, 1, At, B1); PG8_BAR;
            }
        }
        if constexpr (ALIGN_EPI) { if (wr == 0) PG8_BAR; }
        if constexpr (!Epi::AFTER_DRAIN) { E(acc, cur, wr, wc, fr, fq); S.done(cur); }
        if (!has_next) break;
#pragma unroll
        for (int a = 0; a < 2; ++a)
#pragma unroll
            for (int b = 0; b < 2; ++b)
#pragma unroll
                for (int m = 0; m < 4; ++m)
#pragma unroll
                    for (int n = 0; n < 2; ++n) acc[a][b][m][n] = (f32x4){0.f, 0.f, 0.f, 0.f};
        cur = nxt; cA = nA; cB = nB; ++ui;
        if constexpr (ALIGN_EPI) { if (wr == 1) PG8_BAR; }
    }
    PG8_WAIT_V(0);
    if constexpr (!ALIGN_EPI) { if (wr == 0) PG8_BAR; }
    PG8_BAR;
    if constexpr (Epi::AFTER_DRAIN) { E.fused(acc, cur, wr, wc, fr, fq, lds, wid, lane); S.done(cur); }
#undef PG8_SA
#undef PG8_SB
#undef PG8_STAGE
#undef PG8_LDA
#undef PG8_LDB
#undef PG8_MMA
#undef PG8_WAIT_V
#undef PG8_WAIT_L
#undef PG8_BAR
#undef PG8_SCHED
}
}
namespace mk {
using pg8::f32x4; using pg8::u32x4; using pg8::bf16_t; using pg8::Unit;
typedef float f32x2_t __attribute__((ext_vector_type(2))); typedef __bf16 bf16x2_t __attribute__((ext_vector_type(2)));
__device__ __forceinline__ unsigned cvt_pk_bf16(float lo, float hi) { f32x2_t v = {lo, hi}; bf16x2_t b = __builtin_convertvector(v, bf16x2_t); return __builtin_bit_cast(unsigned, b); }
constexpr int NB = 4, SEQ = 8192, DM = 1024, M = NB * SEQ;
constexpr int DFF = 2816, NFF = 2 * DFF;
constexpr int NIN = 4608;
constexpr int NMOD = 9 * DM;
constexpr int QKVW = 768;
constexpr float EPS = 1e-6f;
constexpr float C2 = 0.125f * 1.4426950408889634f;
constexpr int TPB = SEQ / 256;

__device__ __forceinline__ u32x4 pack8(const f32x4 a, const f32x4 b) {
    u32x4 w; w.x = cvt_pk_bf16(a[0], a[1]); w.y = cvt_pk_bf16(a[2], a[3]); w.z = cvt_pk_bf16(b[0], b[1]); w.w = cvt_pk_bf16(b[2], b[3]); return w;
}
__device__ __forceinline__ float bf_lo(unsigned u) { return __uint_as_float(u << 16); }
__device__ __forceinline__ float bf_hi(unsigned u) { return __uint_as_float(u & 0xffff0000u); }
__device__ __forceinline__ float sigmoid_f(float a) { return __builtin_amdgcn_rcpf(1.0f + __builtin_amdgcn_exp2f(-1.4426950408889634f * a)); }
__device__ __forceinline__ f32x4 sigmoid4(const f32x4 a) { f32x4 r; r[0] = sigmoid_f(a[0]); r[1] = sigmoid_f(a[1]); r[2] = sigmoid_f(a[2]); r[3] = sigmoid_f(a[3]); return r; }
__device__ __forceinline__ float row_rstd(const float* ssq, int row, int fq) {
    const f32x4 v = *(const f32x4*)(ssq + (size_t)row * 16 + 4 * fq);
    float s = (v[0] + v[1]) + (v[2] + v[3]);
    s += __shfl_xor(s, 16); s += __shfl_xor(s, 32);
    return __builtin_amdgcn_rsqf(s * (1.0f / (float)DM) + EPS);
}


template <bool NORM> struct EpiSwiglu {
    static constexpr bool PERM = true, AFTER_DRAIN = false;
    bf16_t* H; const float* ssq; const float* bias;
    __device__ __forceinline__ void operator()(const f32x4 (&acc)[2][2][4][2], const Unit& u, int wr, int wc, int fr, int fq) const {
        const int row0 = u.pm * 256 + wr * 64 + fr, hcol = u.pn * 128 + wc * 32 + 8 * fq;
        f32x4 bv[2][2];
        if (NORM) { const float* bp = bias + (size_t)(u.pm / TPB) * NFF + u.pn * 256 + wc * 32 + 8 * fq;
#pragma unroll
            for (int bj = 0; bj < 2; ++bj)
#pragma unroll
                for (int n = 0; n < 2; ++n) bv[bj][n] = *(const f32x4*)(bp + bj * 128 + 4 * n); }
#pragma unroll
        for (int ai = 0; ai < 2; ++ai)
#pragma unroll
            for (int m = 0; m < 4; ++m) {
                const int row = row0 + ai * 128 + m * 16;
                f32x4 a0 = acc[ai][0][m][0], a1 = acc[ai][0][m][1], b0 = acc[ai][1][m][0], b1 = acc[ai][1][m][1];
                if (NORM) { const float rs = row_rstd(ssq, row, fq); a0 = a0 * rs + bv[0][0]; a1 = a1 * rs + bv[0][1]; b0 = b0 * rs + bv[1][0]; b1 = b1 * rs + bv[1][1]; }
                const f32x4 h0 = a0 * sigmoid4(a0) * b0, h1 = a1 * sigmoid4(a1) * b1;
                *(u32x4*)(H + (size_t)row * DFF + hcol) = pack8(h0, h1);
            }
    }
};

typedef _Float16 h16x8 __attribute__((ext_vector_type(8)));
typedef float f32x8 __attribute__((ext_vector_type(8)));
template <bool AOUT, bool HALFG, bool IN16, bool SSQ> struct EpiResid {
    static constexpr bool PERM = true, AFTER_DRAIN = false;
    const void* hin; _Float16* hout; const float* gate; bf16_t* A; const float* g; const float* sc; float* ssq;
    __device__ __forceinline__ void operator()(const f32x4 (&acc)[2][2][4][2], const Unit& u, int wr, int wc, int fr, int fq) const {
        const int b = u.pm / TPB, row0 = u.pm * 256 + wr * 64 + fr, col0 = u.pn * 256 + wc * 32 + 8 * fq;
        f32x4 gt[2][2], gs[2][2];
#pragma unroll
        for (int bj = 0; bj < 2; ++bj)
#pragma unroll
            for (int n = 0; n < 2; ++n) { const int c = col0 + bj * 128 + 4 * n;
                gt[bj][n] = *(const f32x4*)(gate + (size_t)b * NMOD + c) * (HALFG ? 0.5f : 1.0f);
                if (AOUT) gs[bj][n] = *(const f32x4*)(g + c) * (*(const f32x4*)(sc + (size_t)b * NMOD + c) + 1.0f); }
#pragma unroll
        for (int ai = 0; ai < 2; ++ai)
#pragma unroll
            for (int m = 0; m < 4; ++m) {
                const int row = row0 + ai * 128 + m * 16; const size_t off = (size_t)row * DM + col0;
                f32x4 hv[2][2]; float q = 0.f;
#pragma unroll
                for (int bj = 0; bj < 2; ++bj) {
                    f32x4 r0, r1;
                    if (IN16) { const h16x8 rr = *(const h16x8*)((const _Float16*)hin + off + bj * 128); const f32x8 rf = __builtin_convertvector(rr, f32x8);
                        r0 = (f32x4){rf[0], rf[1], rf[2], rf[3]}; r1 = (f32x4){rf[4], rf[5], rf[6], rf[7]}; }
                    else { r0 = *(const f32x4*)((const float*)hin + off + bj * 128); r1 = *(const f32x4*)((const float*)hin + off + bj * 128 + 4); }
                    const f32x4 h0 = r0 + gt[bj][0] * acc[ai][bj][m][0], h1 = r1 + gt[bj][1] * acc[ai][bj][m][1]; hv[bj][0] = h0; hv[bj][1] = h1;
                    const f32x8 hf = {h0[0], h0[1], h0[2], h0[3], h1[0], h1[1], h1[2], h1[3]};
                    *(h16x8*)(hout + off + bj * 128) = __builtin_convertvector(hf, h16x8);
                    if (SSQ) q += ((h0[0] * h0[0] + h0[1] * h0[1]) + (h0[2] * h0[2] + h0[3] * h0[3])) + ((h1[0] * h1[0] + h1[1] * h1[1]) + (h1[2] * h1[2] + h1[3] * h1[3])); }
                if (AOUT) {
#pragma unroll
                    for (int bj = 0; bj < 2; ++bj) *(u32x4*)(A + off + bj * 128) = pack8(hv[bj][0] * gs[bj][0], hv[bj][1] * gs[bj][1]); }
                if (SSQ) { q += __shfl_xor(q, 16); q += __shfl_xor(q, 32);
                    if (fq == 0) ssq[(size_t)row * 16 + 4 * u.pn + wc] = q; }
                if (m & 1) asm volatile("" ::: "memory");
            }
    }
};

struct EpiInProj {
    static constexpr bool PERM = true, AFTER_DRAIN = false;
    const float* ssq; const float* bias; const float* cs; float* PP; bf16_t* Q; bf16_t* K; bf16_t* V; bf16_t* G;
    __device__ __forceinline__ void operator()(const f32x4 (&acc)[2][2][4][2], const Unit& u, int wr, int wc, int fr, int fq) const {
        const int row0 = u.pm * 256 + wr * 64 + fr, pn = u.pn;
        f32x4 bv[2][2];
        { const float* bp = bias + (size_t)(u.pm / TPB) * NIN + pn * 256 + wc * 32 + 8 * fq;
#pragma unroll
            for (int bj = 0; bj < 2; ++bj)
#pragma unroll
                for (int n = 0; n < 2; ++n) bv[bj][n] = *(const f32x4*)(bp + bj * 128 + 4 * n); }
        if (pn == 0) {
#pragma unroll
            for (int ai = 0; ai < 2; ++ai)
#pragma unroll
                for (int m = 0; m < 4; ++m) { const int row = row0 + ai * 128 + m * 16; const float rs = row_rstd(ssq, row, fq);
                    float* dst = PP + (size_t)row * 256 + wc * 32 + 8 * fq;
#pragma unroll
                    for (int bj = 0; bj < 2; ++bj)
#pragma unroll
                        for (int n = 0; n < 2; ++n) *(f32x4*)(dst + bj * 128 + 4 * n) = acc[ai][bj][m][n] * rs + bv[bj][n]; }
        } else if (pn <= 6) {
            const bool isq = pn <= 3; const int head = 4 * (isq ? pn - 1 : pn - 4) + wc; const float osc = isq ? C2 : 1.0f;
            bf16_t* base = (isq ? Q : K) + head * 64 + 8 * fq;
#pragma unroll
            for (int ai = 0; ai < 2; ++ai)
#pragma unroll
                for (int m = 0; m < 4; ++m) { const int row = row0 + ai * 128 + m * 16; const float rs = row_rstd(ssq, row, fq) ;
                    const float* cp = cs + (size_t)row * 64 + 8 * fq;
                    f32x4 o1[2], o2[2];
#pragma unroll
                    for (int n = 0; n < 2; ++n) { const f32x4 c = *(const f32x4*)(cp + 4 * n) * osc, s = *(const f32x4*)(cp + 32 + 4 * n) * osc;
                        const f32x4 x1 = acc[ai][0][m][n] * rs + bv[0][n], x2 = acc[ai][1][m][n] * rs + bv[1][n];
                        o1[n] = x1 * c - x2 * s; o2[n] = x2 * c + x1 * s; }
                    bf16_t* dst = base + (size_t)row * QKVW;
                    *(u32x4*)dst = pack8(o1[0], o1[1]); *(u32x4*)(dst + 32) = pack8(o2[0], o2[1]); }
        } else if (pn <= 9) {
            bf16_t* base = V + (pn - 7) * 256 + wc * 32 + 8 * fq;
#pragma unroll
            for (int ai = 0; ai < 2; ++ai)
#pragma unroll
                for (int m = 0; m < 4; ++m) { const int row = row0 + ai * 128 + m * 16; const float rs = row_rstd(ssq, row, fq);
                    bf16_t* dst = base + (size_t)row * QKVW;
#pragma unroll
                    for (int bj = 0; bj < 2; ++bj) *(u32x4*)(dst + bj * 128) = pack8(acc[ai][bj][m][0] * rs + bv[bj][0], acc[ai][bj][m][1] * rs + bv[bj][1]); }
        } else {
            bf16_t* base = G + (pn - 10) * 256 + wc * 32 + 8 * fq;
#pragma unroll
            for (int ai = 0; ai < 2; ++ai)
#pragma unroll
                for (int m = 0; m < 4; ++m) { const int row = row0 + ai * 128 + m * 16; const float rs = row_rstd(ssq, row, fq);
                    bf16_t* dst = base + (size_t)row * 2048;
#pragma unroll
                    for (int bj = 0; bj < 2; ++bj) *(u32x4*)(dst + bj * 128) = pack8(sigmoid4(acc[ai][bj][m][0] * rs + bv[bj][0]), sigmoid4(acc[ai][bj][m][1] * rs + bv[bj][1])); }
        }
    }
};

struct EpiMerge {
    static constexpr bool PERM = true, AFTER_DRAIN = false;
    const bf16_t* G; bf16_t* Y;
    __device__ __forceinline__ void operator()(const f32x4 (&acc)[2][2][4][2], const Unit& u, int wr, int wc, int fr, int fq) const {
        const int row0 = u.pm * 256 + wr * 64 + fr, c = u.pn * 128 + wc * 32 + 8 * fq;
#pragma unroll
        for (int ai = 0; ai < 2; ++ai)
#pragma unroll
            for (int m = 0; m < 4; ++m) { const int row = row0 + ai * 128 + m * 16;
                const u32x4 gp = *(const u32x4*)(G + (size_t)row * 2048 + c), ga = *(const u32x4*)(G + (size_t)row * 2048 + 1024 + c);
                const f32x4 p0 = {bf_lo(gp.x), bf_hi(gp.x), bf_lo(gp.y), bf_hi(gp.y)}, p1 = {bf_lo(gp.z), bf_hi(gp.z), bf_lo(gp.w), bf_hi(gp.w)};
                const f32x4 a0 = {bf_lo(ga.x), bf_hi(ga.x), bf_lo(ga.y), bf_hi(ga.y)}, a1 = {bf_lo(ga.z), bf_hi(ga.z), bf_lo(ga.w), bf_hi(ga.w)};
                const f32x4 y0 = p0 * acc[ai][0][m][0] + a0 * acc[ai][1][m][0], y1 = p1 * acc[ai][0][m][1] + a1 * acc[ai][1][m][1];
                *(u32x4*)(Y + (size_t)row * DM + c) = pack8(y0, y1); }
    }
};
}

namespace at {
typedef short bf16x8 __attribute__((ext_vector_type(8)));
typedef float f32x16 __attribute__((ext_vector_type(16)));
typedef short v4i16_t __attribute__((ext_vector_type(4)));
typedef __attribute__((address_space(3))) unsigned char* lds_ptr;
constexpr int SEQ = 8192, PITCH = 768;
constexpr float NEG = -INFINITY;

__device__ __forceinline__ unsigned cvt2(float lo, float hi) { typedef float f2 __attribute__((ext_vector_type(2))); typedef __bf16 b2 __attribute__((ext_vector_type(2))); f2 v = {lo, hi}; b2 b = __builtin_convertvector(v, b2); return __builtin_bit_cast(unsigned, b); }

__device__ __forceinline__ void dma_v(const unsigned short* Vh, long rowbase, int dsh, int i0, int kt, lds_ptr slot, int lane) {
#pragma unroll
    for (int u = 0; u < 4; ++u) { int idx = i0 - 128 + 32 * kt + 8 * u + (lane >> 3); idx = idx < 0 ? 0 : idx;
        const unsigned short* src = Vh + (rowbase + ((long)idx << dsh)) * PITCH + 8 * (lane & 7);
        __builtin_amdgcn_global_load_lds((const unsigned*)src, (__attribute__((address_space(3))) unsigned*)(slot + u * 1024), 16, 0, 0); }
}

__device__ __forceinline__ void task(const unsigned short* Qh, const unsigned short* Kh, const unsigned short* Vh, long rowbase, int dsh, int i0,
                                     unsigned short* OGh  , float* LSj  , lds_ptr vlds, int lane) {
    const int q = lane & 31, hh = lane >> 5;
    const int ninv = i0 < 128 ? (128 - i0) >> 5 : 0;
    dma_v(Vh, rowbase, dsh, i0, 0, vlds, lane); dma_v(Vh, rowbase, dsh, i0, 1, vlds + 4096, lane); dma_v(Vh, rowbase, dsh, i0, 2, vlds + 8192, lane); dma_v(Vh, rowbase, dsh, i0, 3, vlds + 12288, lane);
    const long qrow = rowbase + ((long)(i0 + q) << dsh);
    bf16x8 qf[4];
#pragma unroll
    for (int s = 0; s < 4; ++s) qf[s] = *(const bf16x8*)(Qh + qrow * PITCH + 16 * s + 8 * hh);
    f32x16 S[5];
#pragma unroll
    for (int kt = 0; kt < 5; ++kt) { int idx = i0 - 128 + 32 * kt + q; idx = idx < 0 ? 0 : idx;
        const unsigned short* kp = Kh + (rowbase + ((long)idx << dsh)) * PITCH + 8 * hh;
        bf16x8 kf[4];
#pragma unroll
        for (int s = 0; s < 4; ++s) kf[s] = *(const bf16x8*)(kp + 16 * s);
        f32x16 acc = {};
#pragma unroll
        for (int s = 0; s < 4; ++s) acc = __builtin_amdgcn_mfma_f32_32x32x16_bf16(kf[s], qf[s], acc, 0, 0, 0);
        S[kt] = acc; }
    float mx = NEG;
#pragma unroll
    for (int kt = 0; kt < 5; ++kt) {
#pragma unroll
        for (int i = 0; i < 16; ++i) { const int kr = (i & 3) + 8 * (i >> 2) + 4 * hh; bool ok = kt >= ninv;
            if (kt == 0) ok = ok && (kr >= q);
            if (kt == 4) ok = ok && (kr <= q);
            const float v = ok ? S[kt][i] : NEG; S[kt][i] = v; mx = fmaxf(mx, v); } }
    mx = fmaxf(mx, __shfl_xor(mx, 32));
    float l = 0.f;
#pragma unroll
    for (int kt = 0; kt < 5; ++kt)
#pragma unroll
        for (int i = 0; i < 16; ++i) { const float p = __builtin_amdgcn_exp2f(S[kt][i] - mx); S[kt][i] = p; l += p; }
    l += __shfl_xor(l, 32);
    f32x16 O0 = {}, O1 = {};
    const int g4 = lane >> 4, li = lane & 15;
    const int trbase = (4 * (g4 >> 1) + (li >> 2)) * 128 + (16 * (g4 & 1) + 4 * (li & 3)) * 2;
    asm volatile("s_waitcnt vmcnt(0)" ::: "memory");
#define AT_PV(kt, slot) do { _Pragma("unroll") for (int s2 = 0; s2 < 2; ++s2) { \
        union { bf16x8 v; unsigned u[4]; } pf; pf.u[0] = cvt2(S[kt][8 * s2 + 0], S[kt][8 * s2 + 1]); pf.u[1] = cvt2(S[kt][8 * s2 + 2], S[kt][8 * s2 + 3]); pf.u[2] = cvt2(S[kt][8 * s2 + 4], S[kt][8 * s2 + 5]); pf.u[3] = cvt2(S[kt][8 * s2 + 6], S[kt][8 * s2 + 7]); \
        _Pragma("unroll") for (int db = 0; db < 2; ++db) { \
            const lds_ptr p0 = vlds + (slot) * 4096 + trbase + s2 * 16 * 128 + db * 64; \
            const v4i16_t lo = __builtin_amdgcn_ds_read_tr16_b64_v4i16((__attribute__((address_space(3))) v4i16_t*)p0); \
            const v4i16_t hi = __builtin_amdgcn_ds_read_tr16_b64_v4i16((__attribute__((address_space(3))) v4i16_t*)(p0 + 8 * 128)); \
            const bf16x8 vf = {lo[0], lo[1], lo[2], lo[3], hi[0], hi[1], hi[2], hi[3]}; \
            if (db == 0) O0 = __builtin_amdgcn_mfma_f32_32x32x16_bf16(vf, pf.v, O0, 0, 0, 0); else O1 = __builtin_amdgcn_mfma_f32_32x32x16_bf16(vf, pf.v, O1, 0, 0, 0); } } } while (0)
    AT_PV(0, 0);
    asm volatile("s_waitcnt lgkmcnt(0)" ::: "memory");
    dma_v(Vh, rowbase, dsh, i0, 4, vlds, lane);
    AT_PV(1, 1); AT_PV(2, 2); AT_PV(3, 3);
    asm volatile("s_waitcnt vmcnt(0)" ::: "memory");
    AT_PV(4, 0);
#undef AT_PV
    asm volatile("s_waitcnt lgkmcnt(0)" ::: "memory");
    const float rl = 1.0f / l;
    unsigned short* orow = OGh + qrow * 256;
#pragma unroll
    for (int db = 0; db < 2; ++db)
#pragma unroll
        for (int gq = 0; gq < 4; ++gq) { const f32x16& O = db == 0 ? O0 : O1;
            const unsigned long long w = (unsigned long long)cvt2(O[4 * gq] * rl, O[4 * gq + 1] * rl) | ((unsigned long long)cvt2(O[4 * gq + 2] * rl, O[4 * gq + 3] * rl) << 32);
            *(unsigned long long*)(orow + 32 * db + 8 * gq + 4 * hh) = w; }
    if (hh == 0) LSj[qrow * 4] = mx + __log2f(l);
}
}
constexpr int NWAVES = 8;
#ifdef MK_TIMING
constexpr int NPH = 12;
#else
constexpr int NPH = 11;
#endif
#ifndef MK_DOUBLE
#define MK_DOUBLE -1
#endif
#ifndef MK_N_LAUNCHES
#define MK_N_LAUNCHES 1
#endif
constexpr int N_LAUNCHES = MK_N_LAUNCHES;
static_assert(N_LAUNCHES == 1 || N_LAUNCHES == NPH, "MK_N_LAUNCHES is 1 or NPH");

using mk::NB; using mk::SEQ; using mk::DM; using mk::M; using mk::DFF; using mk::NFF; using mk::NIN; using mk::NMOD; using mk::QKVW;

constexpr size_t MiB = 1u << 20;
constexpr size_t WS_CTL = 0, CTL_ZERO_BYTES = 1 * MiB;
constexpr size_t WS_MOD = 1 * MiB;
constexpr size_t WS_BIAS2 = 1 * MiB + 256 * 1024;
constexpr size_t WS_BIAS3 = 1 * MiB + 512 * 1024;
constexpr size_t WS_SSQ2 = 2 * MiB, WS_SSQ3 = 4 * MiB, WS_SSQF = 6 * MiB;
constexpr size_t WS_CS = 8 * MiB;
constexpr size_t WS_W1IN = 16 * MiB, WS_W1OUT = 27 * MiB, WS_WIN = 33 * MiB, WS_WM = 42 * MiB, WS_WOUT = 44 * MiB, WS_W2IN = 46 * MiB, WS_W2OUT = 57 * MiB;
constexpr size_t WS_XA = 64 * MiB;
constexpr size_t WS_YA = 128 * MiB;
constexpr size_t WS_PP = 160 * MiB;
constexpr size_t WS_Q = 192 * MiB, WS_K = 240 * MiB, WS_V = 288 * MiB;
constexpr size_t WS_G = 336 * MiB;
constexpr size_t WS_MERGED = 192 * MiB;
constexpr size_t WS_HID = 192 * MiB;
constexpr size_t WS_END = 464 * MiB;
static_assert(WS_W1IN + (size_t)NFF * DM * 2 <= WS_W1OUT && WS_W1OUT + (size_t)DM * DFF * 2 <= WS_WIN && WS_WIN + (size_t)NIN * DM * 2 <= WS_WM && WS_WM + (size_t)2048 * 512 * 2 <= WS_WOUT &&
              WS_WOUT + (size_t)DM * DM * 2 <= WS_W2IN && WS_W2IN + (size_t)NFF * DM * 2 <= WS_W2OUT && WS_W2OUT + (size_t)DM * DFF * 2 <= WS_XA, "weight map");
static_assert(WS_HID + (size_t)M * DFF * 2 <= WS_END && WS_G + (size_t)M * 2048 * 2 <= WS_END && WS_MERGED + (size_t)M * DM * 2 <= WS_V, "activation map");
constexpr int CW_BAR = 4096;

constexpr int RING_OFF = 0, RING_BYTES = 131072;
constexpr int LDSCTL_OFF = RING_BYTES, MISC_OFF = LDSCTL_OFF + 320;
constexpr int LDS_BYTES = 147456;
static_assert(MISC_OFF + 128 <= LDS_BYTES, "LDS map");

#define GAS __attribute__((address_space(1)))
#define LAS __attribute__((address_space(3)))
typedef unsigned short bf16;
typedef unsigned v4u __attribute__((ext_vector_type(4)));
typedef float f32x4 __attribute__((ext_vector_type(4)));
typedef short bf16x8 __attribute__((ext_vector_type(8)));
typedef GAS unsigned gu32;
typedef GAS unsigned long long gu64;
#define RLX_AGENT __ATOMIC_RELAXED, __HIP_MEMORY_SCOPE_AGENT
#define LDS_WAIT() asm volatile("s_waitcnt lgkmcnt(0)" ::: "memory")
#define VM_WAIT() asm volatile("s_waitcnt vmcnt(0)" ::: "memory")
__device__ __forceinline__ unsigned long long rt() { return __builtin_amdgcn_s_memrealtime(); }
__device__ __forceinline__ unsigned f2bf(float f) { unsigned u = __builtin_bit_cast(unsigned, f); return (u + 0x7fffu + ((u >> 16) & 1u)) >> 16; }
__device__ __forceinline__ unsigned pk2(float lo, float hi) { return f2bf(lo) | (f2bf(hi) << 16); }

#define XB_TMO      128
#define XB_XCNT(j)  (256  + 64 * (j))
#define XB_XSUB(j)  (1280 + 64 * (j))
#define XB_XGEN(j)  (2304 + 64 * (j))
#define XB_TOP      3328
#define XB_TOPGEN   3392
#define XCD_BAR_WORDS 3456
#define XB_SPIN_CAP (1u << 18)

__device__ __forceinline__ unsigned xb_ld(unsigned* p)              { return __hip_atomic_load(p, __ATOMIC_RELAXED, __HIP_MEMORY_SCOPE_AGENT); }
__device__ __forceinline__ unsigned xb_add(unsigned* p, unsigned v) { return __hip_atomic_fetch_add(p, v, __ATOMIC_RELAXED, __HIP_MEMORY_SCOPE_AGENT); }
__device__ __forceinline__ unsigned xb_xcc_id() { return (unsigned)__builtin_amdgcn_s_getreg((3 << 11) | 20) & 0xFu; }
#define XB_SPIN(cond, bar) do { unsigned _sp = 0; while (cond) { __builtin_amdgcn_s_sleep(1); \
    if ((++_sp & 255u) == 0u) { if (xb_ld(&(bar)[XB_TMO])) break; if (_sp > XB_SPIN_CAP) { atomicAdd(&(bar)[XB_TMO], 1u); break; } } } } while (0)

struct XcdBarrier {
    unsigned* bar; unsigned x;
    volatile LAS unsigned* st;
};

__device__ __forceinline__ XcdBarrier xcd_barrier_post(unsigned* bar, volatile LAS unsigned* st) {
    XcdBarrier b; b.bar = bar; b.x = xb_xcc_id(); b.st = st;
    if (threadIdx.x == 0) (void)xb_add(&bar[XB_XCNT(b.x)], 1u);
    return b;
}
__device__ __forceinline__ void xcd_barrier_complete(unsigned* bar, unsigned x, unsigned& nloc, unsigned& nx) {
    const unsigned G = gridDim.x * gridDim.y * gridDim.z;
    unsigned sum, cnt, mine, sp = 0u;
    for (;;) {
        sum = 0u; cnt = 0u; mine = 0u;
#pragma unroll
        for (unsigned j = 0; j < 16; ++j) { const unsigned c = xb_ld(&bar[XB_XCNT(j)]); sum += c; cnt += (c > 0u) ? 1u : 0u; mine = (j == x) ? c : mine; }
        if (sum == G) break;
        __builtin_amdgcn_s_sleep(1);
        if ((++sp & 255u) == 0u) { if (xb_ld(&bar[XB_TMO])) break; if (sp > XB_SPIN_CAP) { atomicAdd(&bar[XB_TMO], 1u); break; } }
    }
    nloc = mine > 0u ? mine : 1u; nx = cnt > 0u ? cnt : 1u;
}

__device__ __forceinline__ void xcd_barrier(const XcdBarrier& b) {
    asm volatile("s_waitcnt vmcnt(0)" ::: "memory");
    __syncthreads();
    if (threadIdx.x == 0) {
        unsigned* bar = b.bar;
        __builtin_amdgcn_s_waitcnt(0);
        unsigned nloc = b.st[0], nx = b.st[1];
        if (nloc == 0u) { xcd_barrier_complete(bar, b.x, nloc, nx); b.st[0] = nloc; b.st[1] = nx; }
        const unsigned old = xb_add(&bar[XB_XSUB(b.x)], 1u);
        const unsigned gen = old / nloc;
        if (old + 1u == (gen + 1u) * nloc) {
            __builtin_amdgcn_fence(__ATOMIC_RELEASE, "agent");
            asm volatile("s_waitcnt vmcnt(0)" ::: "memory");
            const unsigned og = xb_add(&bar[XB_TOP], 1u);
            const unsigned tg = og / nx;
            if (og + 1u == (tg + 1u) * nx) xb_add(&bar[XB_TOPGEN], 1u);
            else XB_SPIN(xb_ld(&bar[XB_TOPGEN]) == tg, bar);
            __builtin_amdgcn_fence(__ATOMIC_ACQUIRE, "agent");
            xb_add(&bar[XB_XGEN(b.x)], 1u);
            asm volatile("s_waitcnt vmcnt(0)" ::: "memory");
        } else {
            XB_SPIN(xb_ld(&bar[XB_XGEN(b.x)]) == gen, bar);
            __builtin_amdgcn_fence(__ATOMIC_ACQUIRE, "agent");
            asm volatile("s_waitcnt vmcnt(0)" ::: "memory");
        }
    }
    __syncthreads();
}

struct Frame {
    LAS unsigned char* lds;
    volatile LAS unsigned* MISC;
    gu32* ctl;
    int tid, lane, wave;
    int vcu, G;
};
__device__ __forceinline__ float wave_sum(float v) {
#pragma unroll
    for (int o = 1; o < 64; o <<= 1) v += __shfl_xor(v, o);
    return v;
}
__device__ __forceinline__ float wave_max(float v) {
#pragma unroll
    for (int o = 1; o < 64; o <<= 1) v = fmaxf(v, __shfl_xor(v, o));
    return v;
}
__device__ __forceinline__ float silu_f(float a) { return a * mk::sigmoid_f(a); }

__device__ __forceinline__ void tr_item(const float* W, int N, int k0, int n0, bf16* WT, int Kd, int dst_row0, int dst_k0, LAS float* scr, int lane) {
#pragma unroll 8
    for (int i = 0; i < 32; ++i) { const int kk = 2 * i + (lane >> 5); scr[kk * 33 + (lane & 31)] = W[(size_t)(k0 + kk) * N + n0 + (lane & 31)]; }
    LDS_WAIT(); asm volatile("" ::: "memory");
    const int c = lane & 7;
#pragma unroll
    for (int j = 0; j < 4; ++j) { const int n = (lane >> 3) + 8 * j; const LAS float* s = scr + (8 * c) * 33 + n;
        v4u o; o.x = pk2(s[0 * 33], s[1 * 33]); o.y = pk2(s[2 * 33], s[3 * 33]); o.z = pk2(s[4 * 33], s[5 * 33]); o.w = pk2(s[6 * 33], s[7 * 33]);
        *(v4u*)(WT + (size_t)(dst_row0 + n) * Kd + dst_k0 + 8 * c) = o; }
    LDS_WAIT(); asm volatile("" ::: "memory");
}
__device__ __forceinline__ void zero_item(bf16* WT, int Kd, int dst_row0, int dst_k0, int lane) {
    const int c = lane & 7;
#pragma unroll
    for (int j = 0; j < 4; ++j) { const int n = (lane >> 3) + 8 * j; *(v4u*)(WT + (size_t)(dst_row0 + n) * Kd + dst_k0 + 8 * c) = (v4u){0u, 0u, 0u, 0u}; }
}
__device__ __forceinline__ int ffn_row0(int n0) { const int half = n0 >= DFF ? 1 : 0, j = n0 - half * DFF; return 256 * (j >> 7) + 128 * half + (j & 127); }
__device__ __forceinline__ int inproj_row0(int n0) {
    if (n0 < 1024) { const int e = n0 - 256, head = e >> 6, bj = (e >> 5) & 1; return 256 * (1 + (head >> 2)) + 128 * bj + 32 * (head & 3); }
    if (n0 < 1792) { const int e = n0 - 1024, head = e >> 6, bj = (e >> 5) & 1; return 256 * (4 + (head >> 2)) + 128 * bj + 32 * (head & 3); }
    return n0;
}

struct Ptrs {
    const float *x, *c; const int* pos; const float *w_ada, *b_ada, *g1, *w1in, *w1out, *g2, *w_in, *w_pool, *pool_scale, *w_pb, *w_ab, *w_out, *g3, *w2in, *w2out, *gf;
    float* out; unsigned char* ws;
};

__constant__ float INV_FREQ[32] = {
    1.0f, 0.74989420933f, 0.56234132519f, 0.42169650343f, 0.31622776602f, 0.23713737057f, 0.17782794100f, 0.13335214322f,
    0.1f, 0.074989420933f, 0.056234132519f, 0.042169650343f, 0.031622776602f, 0.023713737057f, 0.017782794100f, 0.013335214322f,
    0.01f, 0.0074989420933f, 0.0056234132519f, 0.0042169650343f, 0.0031622776602f, 0.0023713737057f, 0.0017782794100f, 0.0013335214322f,
    0.001f, 0.00074989420933f, 0.00056234132519f, 0.00042169650343f, 0.00031622776602f, 0.00023713737057f, 0.00017782794100f, 0.00013335214322f };

__device__ __forceinline__ void p0_prologue(Frame& F, const Ptrs& P) {
    unsigned char* ws = P.ws;
    float* mod = (float*)(ws + WS_MOD);
    {
        LAS float* cond = (LAS float*)(F.lds + RING_OFF);
        LAS float* red = (LAS float*)(F.lds + RING_OFF + 16384);
        for (int i = F.tid; i < NB * DM; i += NWAVES * 64) { const int b = i >> 10, k = i & 1023; cond[k * 4 + b] = silu_f(P.c[i]); }
        __syncthreads();
        for (int item = F.vcu; item < NMOD / 64; item += F.G) {
            const int n = item * 64 + F.lane; float a0 = 0.f, a1 = 0.f, a2 = 0.f, a3 = 0.f;
            const float* wp = P.w_ada + (size_t)(F.wave * 128) * NMOD + n;
#pragma unroll 8
            for (int k = 0; k < 128; ++k) { const float w = wp[(size_t)k * NMOD]; const LAS float* cp = cond + (F.wave * 128 + k) * 4; a0 += cp[0] * w; a1 += cp[1] * w; a2 += cp[2] * w; a3 += cp[3] * w; }
            red[(F.wave * 4 + 0) * 64 + F.lane] = a0; red[(F.wave * 4 + 1) * 64 + F.lane] = a1; red[(F.wave * 4 + 2) * 64 + F.lane] = a2; red[(F.wave * 4 + 3) * 64 + F.lane] = a3;
            __syncthreads();
            if (F.wave < 4) { float s = P.b_ada[n];
#pragma unroll
                for (int w = 0; w < 8; ++w) s += red[(w * 4 + F.wave) * 64 + F.lane];
                mod[(size_t)F.wave * NMOD + n] = s; }
            __syncthreads();
        }
    }
    LAS float* scr = (LAS float*)(F.lds + RING_OFF + F.wave * 16384);
    const int gw = F.vcu * NWAVES + F.wave, NGW = F.G * NWAVES;
    constexpr int I_FIN = (DM / 64) * (NFF / 32);
    constexpr int I_FOUT = (DFF / 64) * (DM / 32);
    constexpr int I_IN = (DM / 64) * ((NIN - 256) / 32);
    constexpr int I_BR = (256 / 64) * (DM / 32);
    constexpr int I_OUT = (DM / 64) * (DM / 32);
    constexpr int I_POOL = (DM / 64) * (256 / 32);
    constexpr int I_CS = M / 64;
    constexpr int NITEMS = 2 * I_FIN + 2 * I_FOUT + I_IN + 2 * I_BR + I_OUT + I_POOL + I_CS;
    bf16* W1IN = (bf16*)(ws + WS_W1IN); bf16* W1OUT = (bf16*)(ws + WS_W1OUT); bf16* WIN = (bf16*)(ws + WS_WIN); bf16* WM = (bf16*)(ws + WS_WM);
    bf16* WOUT = (bf16*)(ws + WS_WOUT); bf16* W2IN = (bf16*)(ws + WS_W2IN); bf16* W2OUT = (bf16*)(ws + WS_W2OUT);
    for (int it = gw; it < NITEMS; it += NGW) {
        int r = it;
        if (r < 2 * I_FIN) { const bool second = r >= I_FIN; if (second) r -= I_FIN; const int nblk = NFF / 32, kb = r / nblk, nb = r % nblk;
            tr_item(second ? P.w2in : P.w1in, NFF, 64 * kb, 32 * nb, second ? W2IN : W1IN, DM, ffn_row0(32 * nb), 64 * kb, scr, F.lane); continue; }
        r -= 2 * I_FIN;
        if (r < 2 * I_FOUT) { const bool second = r >= I_FOUT; if (second) r -= I_FOUT; const int nblk = DM / 32, kb = r / nblk, nb = r % nblk;
            tr_item(second ? P.w2out : P.w1out, DM, 64 * kb, 32 * nb, second ? W2OUT : W1OUT, DFF, 32 * nb, 64 * kb, scr, F.lane); continue; }
        r -= 2 * I_FOUT;
        if (r < I_IN) { const int nblk = (NIN - 256) / 32, kb = r / nblk, nb = r % nblk, n0 = 256 + 32 * nb;
            tr_item(P.w_in, NIN, 64 * kb, n0, WIN, DM, inproj_row0(n0), 64 * kb, scr, F.lane); continue; }
        r -= I_IN;
        if (r < 2 * I_BR) { const bool attn = r >= I_BR; if (attn) r -= I_BR; const int nblk = DM / 32, kb = r / nblk, nb = r % nblk, n0 = 32 * nb;
            const int row0 = 256 * (n0 >> 7) + (attn ? 128 : 0) + (n0 & 127);
            tr_item(attn ? P.w_ab : P.w_pb, DM, 64 * kb, n0, WM, 512, row0, (attn ? 256 : 0) + 64 * kb, scr, F.lane);
            zero_item(WM, 512, row0, (attn ? 0 : 256) + 64 * kb, F.lane); continue; }
        r -= 2 * I_BR;
        if (r < I_OUT) { const int nblk = DM / 32, kb = r / nblk, nb = r % nblk;
            tr_item(P.w_out, DM, 64 * kb, 32 * nb, WOUT, DM, 32 * nb, 64 * kb, scr, F.lane); continue; }
        r -= I_OUT;
        if (r < I_POOL) {
            const int kb = r / 8, nb = r % 8, g = nb >> 1, dd0 = (nb & 1) * 32, k = 64 * kb + F.lane;
            const float* wr = P.w_in + (size_t)k * NIN + 64 * g; const float* wp = P.w_pool + (size_t)g * 4096 + dd0;
            float o[32];
#pragma unroll
            for (int d = 0; d < 32; ++d) o[d] = 0.f;
            for (int c4 = 0; c4 < 16; ++c4) { const f32x4 a = *(const f32x4*)(wr + 4 * c4);
#pragma unroll
                for (int ci = 0; ci < 4; ++ci) { const float av = a[ci]; const float* wq = wp + (size_t)(4 * c4 + ci) * 64;
#pragma unroll
                    for (int d = 0; d < 32; ++d) o[d] += av * wq[d]; } }
#pragma unroll
            for (int d = 0; d < 32; ++d) { const int np = 32 * nb + d; WIN[(size_t)np * DM + k] = (bf16)f2bf(o[d] * P.pool_scale[np]); }
            continue; }
        r -= I_POOL;
        {
            const int f = F.lane & 31; const float invf = INV_FREQ[f];
            float* cs = (float*)(ws + WS_CS);
            for (int i = 0; i < 32; ++i) { const int m = 64 * r + 2 * i + (F.lane >> 5);
                const float ang = (float)P.pos[m] * invf;
                const double a = (double)ang; const double kq = rint(a * 0.15915494309189535); const double red = fma(-kq, 6.283185307179586, a) - kq * 2.4492935982947064e-16;
                const float rr = (float)red;
                cs[(size_t)m * 64 + f] = cosf(rr); cs[(size_t)m * 64 + 32 + f] = sinf(rr); }
        }
    }
}

__device__ __forceinline__ void p1_prologue(Frame& F, const Ptrs& P) {
    unsigned char* ws = P.ws; const float* mod = (const float*)(ws + WS_MOD);
    const int gw = F.vcu * NWAVES + F.wave, NGW = F.G * NWAVES;
    bf16* XA = (bf16*)(ws + WS_XA);
    for (int m = gw; m < M; m += NGW) {
        const int b = m / SEQ; const f32x4* xr = (const f32x4*)(P.x + (size_t)m * DM) + F.lane;
        f32x4 v[4]; float s = 0.f;
#pragma unroll
        for (int j = 0; j < 4; ++j) { v[j] = xr[64 * j]; s += (v[j].x * v[j].x + v[j].y * v[j].y) + (v[j].z * v[j].z + v[j].w * v[j].w); }
        const float rstd = __builtin_amdgcn_rsqf(wave_sum(s) * (1.f / DM) + mk::EPS);
        unsigned long long* o8 = (unsigned long long*)(XA + (size_t)m * DM) + F.lane;
#pragma unroll
        for (int j = 0; j < 4; ++j) { const int c = 4 * F.lane + 256 * j;
            const f32x4 g = *(const f32x4*)(P.g1 + c), sh = *(const f32x4*)(mod + (size_t)b * NMOD + c), sc = *(const f32x4*)(mod + (size_t)b * NMOD + DM + c);
            const f32x4 y = (v[j] * rstd * g) * (sc + 1.0f) + sh;
            o8[64 * j] = (unsigned long long)pk2(y.x, y.y) | ((unsigned long long)pk2(y.z, y.w) << 32); }
    }
    for (int it = gw; it < NIN + NFF; it += NGW) {
        const bool second = it >= NIN; const int n = second ? it - NIN : it;
        const bf16* wrow = (const bf16*)(ws + (second ? WS_W2IN : WS_WIN)) + (size_t)n * DM + 16 * F.lane;
        const v4u w0 = *(const v4u*)wrow, w1 = *(const v4u*)(wrow + 8);
        float wv[16] = { mk::bf_lo(w0.x), mk::bf_hi(w0.x), mk::bf_lo(w0.y), mk::bf_hi(w0.y), mk::bf_lo(w0.z), mk::bf_hi(w0.z), mk::bf_lo(w0.w), mk::bf_hi(w0.w),
                         mk::bf_lo(w1.x), mk::bf_hi(w1.x), mk::bf_lo(w1.y), mk::bf_hi(w1.y), mk::bf_lo(w1.z), mk::bf_hi(w1.z), mk::bf_lo(w1.w), mk::bf_hi(w1.w) };
        float* dst = (float*)(ws + (second ? WS_BIAS3 : WS_BIAS2));
        const int shoff = (second ? 6 : 3) * DM;
#pragma unroll
        for (int b = 0; b < NB; ++b) { const float* sh = mod + (size_t)b * NMOD + shoff + 16 * F.lane; float s = 0.f;
#pragma unroll
            for (int q = 0; q < 4; ++q) { const f32x4 t = *(const f32x4*)(sh + 4 * q); s += (t.x * wv[4 * q] + t.y * wv[4 * q + 1]) + (t.z * wv[4 * q + 2] + t.w * wv[4 * q + 3]); }
            s = wave_sum(s);
            if (F.lane == 0) dst[(size_t)b * (second ? NFF : NIN) + n] = s; }
    }
}

constexpr size_t WS_OG = WS_XA;
constexpr size_t WS_LS = WS_SSQ3;
static_assert(3 * (size_t)M * 256 * 2 <= 64 * MiB && 3 * (size_t)M * 4 * 4 <= 2 * MiB, "attention scratch fits its hosts");
__device__ __forceinline__ void p5_mixers(Frame& F, const Ptrs& P) {
    unsigned char* ws = P.ws;
    const float* PP = (const float*)(ws + WS_PP); bf16* YA = (bf16*)(ws + WS_YA);
    const bf16* Q = (const bf16*)(ws + WS_Q); const bf16* K = (const bf16*)(ws + WS_K); const bf16* V = (const bf16*)(ws + WS_V);
    bf16* OG = (bf16*)(ws + WS_OG); float* LS = (float*)(ws + WS_LS);
    const int gw = F.vcu * NWAVES + F.wave, NGW = F.G * NWAVES;
    for (int u = F.vcu; u < 256; u += F.G) {
        const int b = u >> 6, j = (u >> 4) & 3, beta = u & 15;
        for (int tau = F.wave; tau < 48; tau += NWAVES) {
            const int g = tau >> 4, x = tau & 15, dsh = 2 * g, h = 4 * g + j;
            const int r = g == 0 ? 0 : (g == 1 ? (x >> 2) : x);
            const int i0 = g == 0 ? 512 * beta + 32 * x : (g == 1 ? 128 * beta + 32 * (x & 3) : 32 * beta);
            at::task(Q + h * 64, K + h * 64, V + h * 64, (long)b * SEQ + r, dsh, i0, OG + (size_t)g * M * 256 + j * 64, LS + (size_t)g * M * 4 + j,
                     (at::lds_ptr)(F.lds + RING_OFF + F.wave * 16384), F.lane);
        }
        asm volatile("s_waitcnt vmcnt(0)" ::: "memory");
        __syncthreads();
        __builtin_amdgcn_fence(__ATOMIC_ACQUIRE, "agent");
        asm volatile("s_waitcnt vmcnt(0)" ::: "memory");
        for (int it = 0; it < 8; ++it) {
            const size_t row = (size_t)b * SEQ + 512 * beta + 64 * it + (F.tid >> 3); const int ch = F.tid & 7;
            float ls[3]; v4u ov[3];
#pragma unroll
            for (int g = 0; g < 3; ++g) { ls[g] = LS[((size_t)g * M + row) * 4 + j]; ov[g] = *(const v4u*)(OG + ((size_t)g * M + row) * 256 + j * 64 + 8 * ch); }
            const float mx = fmaxf(fmaxf(ls[0], ls[1]), ls[2]);
            const float e0 = __builtin_amdgcn_exp2f(ls[0] - mx), e1 = __builtin_amdgcn_exp2f(ls[1] - mx), e2 = __builtin_amdgcn_exp2f(ls[2] - mx), rs = 1.0f / (e0 + e1 + e2);
            const float w0 = e0 * rs, w1 = e1 * rs, w2 = e2 * rs;
            v4u o;
#define JOIN(c) { const float lo = w0 * mk::bf_lo(ov[0].c) + w1 * mk::bf_lo(ov[1].c) + w2 * mk::bf_lo(ov[2].c), hi = w0 * mk::bf_hi(ov[0].c) + w1 * mk::bf_hi(ov[1].c) + w2 * mk::bf_hi(ov[2].c); o.c = pk2(lo, hi); }
            JOIN(x) JOIN(y) JOIN(z) JOIN(w)
#undef JOIN
            *(v4u*)(YA + row * 512 + 256 + j * 64 + 8 * ch) = o;
        }
        __syncthreads();
    }
    for (int c = gw; c < M / 16; c += NGW) {
        const int R0 = 16 * c, t0 = R0 % SEQ, w = 2 << (F.lane >> 4);
        const float* p = PP + (size_t)R0 * 256 + 4 * F.lane;
        f32x4 s = {0.f, 0.f, 0.f, 0.f};
        for (int jj = 1; jj < w; ++jj) if (t0 - jj >= 0) s += *(const f32x4*)(p - (size_t)jj * 256);
#pragma unroll 4
        for (int k = 0; k < 16; ++k) { const int t = t0 + k; const f32x4 cur = *(const f32x4*)(p + (size_t)k * 256); s += cur;
            const int cnt = (t + 1 < w) ? t + 1 : w;
            const f32x4 y = s * (1.0f / (float)cnt) - cur;
            *(unsigned long long*)(YA + (size_t)(R0 + k) * 512 + 4 * F.lane) = (unsigned long long)pk2(y.x, y.y) | ((unsigned long long)pk2(y.z, y.w) << 32);
            if (t + 1 - w >= 0) s -= *(const f32x4*)(p + (size_t)(k + 1 - w) * 256); }
    }
}

__device__ __forceinline__ void p10_final_norm(Frame& F, const Ptrs& P) {
    const int gw = F.vcu * NWAVES + F.wave, NGW = F.G * NWAVES;
    const _Float16* H3 = (const _Float16*)(P.ws + WS_XA);
    for (int m = gw; m < M; m += NGW) {
        mk::f32x8 v[2]; float s = 0.f;
#pragma unroll
        for (int j = 0; j < 2; ++j) { v[j] = __builtin_convertvector(*(const mk::h16x8*)(H3 + (size_t)m * DM + 8 * F.lane + 512 * j), mk::f32x8);
#pragma unroll
            for (int e = 0; e < 8; ++e) s += v[j][e] * v[j][e]; }
        const float rstd = __builtin_amdgcn_rsqf(wave_sum(s) * (1.f / DM) + mk::EPS);
#pragma unroll
        for (int j = 0; j < 2; ++j) { const int c = 8 * F.lane + 512 * j; const f32x4 g0 = *(const f32x4*)(P.gf + c), g1 = *(const f32x4*)(P.gf + c + 4);
            *(f32x4*)(P.out + (size_t)m * DM + c) = (f32x4){v[j][0], v[j][1], v[j][2], v[j][3]} * rstd * g0;
            *(f32x4*)(P.out + (size_t)m * DM + c + 4) = (f32x4){v[j][4], v[j][5], v[j][6], v[j][7]} * rstd * g1; }
    }
}

struct Args { Ptrs p; int ph_lo, ph_hi, li, pad; };
__global__ void __launch_bounds__(NWAVES * 64, 2) mk_fwd(Args args) {
    extern __shared__ __attribute__((aligned(16))) unsigned char lds[];
    Frame F;
    F.lds = (LAS unsigned char*)lds;
    F.MISC = (volatile LAS unsigned*)(F.lds + MISC_OFF);
    F.tid = threadIdx.x; F.lane = F.tid & 63; F.wave = __builtin_amdgcn_readfirstlane(F.tid >> 6);
    F.G = gridDim.x; { const int bx = blockIdx.x; F.vcu = (F.G % 8 == 0) ? (bx % 8) * (F.G / 8) + bx / 8 : bx; }
    const Ptrs& P = args.p;
    unsigned char* ws = P.ws;
    F.ctl = (gu32*)(ws + WS_CTL);
    for (int u = F.tid; u < (LDS_BYTES - LDSCTL_OFF) / 4; u += NWAVES * 64) ((LAS unsigned*)(F.lds + LDSCTL_OFF))[u] = 0u;
    __syncthreads();
    XcdBarrier bar = xcd_barrier_post((unsigned*)(F.ctl + CW_BAR) + args.li * XCD_BAR_WORDS, F.MISC + 8);
#ifdef MK_TIMING
    constexpr int CW_TS = 65536; int n_stamp = 0;
    if (blockIdx.x == 0 && F.tid == 0) __hip_atomic_store((unsigned long long*)(F.ctl + CW_TS), rt(), RLX_AGENT);
#define GRID_BAR() do { xcd_barrier(bar); ++n_stamp; if (blockIdx.x == 0 && F.tid == 0) __hip_atomic_store((unsigned long long*)(F.ctl + CW_TS) + n_stamp, rt(), RLX_AGENT); } while (0)
#else
#define GRID_BAR() xcd_barrier(bar)
#endif
    const int lo = args.ph_lo, hi = args.ph_hi;
#define IN(k) (lo <= (k) && (k) < hi)
#define BOTH(k) (IN(k) && IN((k) + 1))
    float* mod = (float*)(ws + WS_MOD);
    bf16* XA = (bf16*)(ws + WS_XA); bf16* HID = (bf16*)(ws + WS_HID);
    float* SSQ2 = (float*)(ws + WS_SSQ2); float* SSQ3 = (float*)(ws + WS_SSQ3);
    _Float16* H16 = (_Float16*)P.out;

    if (IN(0)) { p0_prologue(F, P); if (BOTH(0)) GRID_BAR(); }
    if (IN(1)) { p1_prologue(F, P); if (BOTH(1)) GRID_BAR(); }
    if (IN(2)) {
        pg8::Gemm g{XA, (const bf16*)(ws + WS_W1IN), M, NFF, DM}; pg8::StaticOrder S; S.init(M, NFF, F.G, (int)blockIdx.x);
        mk::EpiSwiglu<false> E{HID, nullptr, nullptr};
        pg8::gemm_phase<mk::EpiSwiglu<false>, pg8::StaticOrder, true, true>(F.lds + RING_OFF, g, S, E);
        if (BOTH(2)) GRID_BAR();
    }
    if (IN(3)) {
        pg8::Gemm g{HID, (const bf16*)(ws + WS_W1OUT), M, DM, DFF}; pg8::StaticOrder S; S.init(M, DM, F.G, (int)blockIdx.x);
        mk::EpiResid<true, true, false, true> E{P.x, H16, mod + 2 * DM, XA, P.g2, mod + 4 * DM, SSQ2};
        pg8::gemm_phase<mk::EpiResid<true, true, false, true>, pg8::StaticOrder, true, true>(F.lds + RING_OFF, g, S, E);
        if (BOTH(3)) GRID_BAR();
    }
    if (IN(4)) {
        pg8::Gemm g{XA, (const bf16*)(ws + WS_WIN), M, NIN, DM}; pg8::StaticOrder S; S.init(M, NIN, F.G, (int)blockIdx.x);
        mk::EpiInProj E{SSQ2, (const float*)(ws + WS_BIAS2), (const float*)(ws + WS_CS), (float*)(ws + WS_PP), (bf16*)(ws + WS_Q), (bf16*)(ws + WS_K), (bf16*)(ws + WS_V), (bf16*)(ws + WS_G)};
        pg8::gemm_phase<mk::EpiInProj, pg8::StaticOrder, true, true>(F.lds + RING_OFF, g, S, E);
        if (BOTH(4)) GRID_BAR();
    }
    if (IN(5)) { p5_mixers(F, P); if (BOTH(5)) GRID_BAR(); }
    if (IN(6)) {
        pg8::Gemm g{(const bf16*)(ws + WS_YA), (const bf16*)(ws + WS_WM), M, 2048, 512}; pg8::StaticOrder S; S.init(M, 2048, F.G, (int)blockIdx.x);
        mk::EpiMerge E{(const bf16*)(ws + WS_G), (bf16*)(ws + WS_MERGED)};
        pg8::gemm_phase<mk::EpiMerge, pg8::StaticOrder, true, true>(F.lds + RING_OFF, g, S, E);
        if (BOTH(6)) GRID_BAR();
    }
    if (IN(7)) {
        pg8::Gemm g{(const bf16*)(ws + WS_MERGED), (const bf16*)(ws + WS_WOUT), M, DM, DM}; pg8::StaticOrder S; S.init(M, DM, F.G, (int)blockIdx.x);
        mk::EpiResid<true, false, true, true> E{H16, H16, mod + 5 * DM, XA, P.g3, mod + 7 * DM, SSQ3};
        pg8::gemm_phase<mk::EpiResid<true, false, true, true>, pg8::StaticOrder, true, true>(F.lds + RING_OFF, g, S, E);
        if (BOTH(7)) GRID_BAR();
    }
    if (IN(8)) {
        pg8::Gemm g{XA, (const bf16*)(ws + WS_W2IN), M, NFF, DM}; pg8::StaticOrder S; S.init(M, NFF, F.G, (int)blockIdx.x);
        mk::EpiSwiglu<true> E{HID, SSQ3, (const float*)(ws + WS_BIAS3)};
        pg8::gemm_phase<mk::EpiSwiglu<true>, pg8::StaticOrder, true, true>(F.lds + RING_OFF, g, S, E);
        if (BOTH(8)) GRID_BAR();
    }
    if (IN(9)) {
        pg8::Gemm g{HID, (const bf16*)(ws + WS_W2OUT), M, DM, DFF}; pg8::StaticOrder S; S.init(M, DM, F.G, (int)blockIdx.x);
        mk::EpiResid<false, true, true, false> E{H16, (_Float16*)XA, mod + 8 * DM, nullptr, nullptr, nullptr, nullptr};
        pg8::gemm_phase<mk::EpiResid<false, true, true, false>, pg8::StaticOrder, true, true>(F.lds + RING_OFF, g, S, E);
        if (BOTH(9)) GRID_BAR();
    }
    if (IN(10)) { p10_final_norm(F, P); if (BOTH(10)) GRID_BAR(); }
#ifdef MK_TIMING
    if (IN(11)) {
        const unsigned long long* ts = (const unsigned long long*)(F.ctl + CW_TS);
        const unsigned long long a0 = __hip_atomic_load(ts + MK_TIMING, RLX_AGENT), a1 = __hip_atomic_load(ts + MK_TIMING + 1, RLX_AGENT), a2 = __hip_atomic_load(ts + MK_TIMING + 2, RLX_AGENT);
        const float ta = (float)(a1 - a0) * 0.01f, tb = (float)(a2 - a1) * 0.01f;
        for (size_t i = (size_t)blockIdx.x * 512 + F.tid; i < 8388608; i += (size_t)F.G * 512) P.out[1048576 + i] = 10.0f * tb;
        if (blockIdx.x == 0 && F.tid == 0) P.out[0] = 1e3f * ta;
    }
#endif
#undef IN
#undef BOTH
#undef GRID_BAR
}

extern "C" void kernel_launch(void* const* d_in, const int* in_sizes, int n_in, void* d_out, int out_size, void* d_ws, size_t ws_size, hipStream_t stream) {
    static int grid = 0;
    if (grid == 0) {
        if (n_in != 19 || in_sizes[0] != M * DM || out_size != M * DM || ws_size < WS_END) { fprintf(stderr, "kernel_launch: unexpected shapes (n_in %d, in0 %d, out %d, ws %zu); nothing launched\n", n_in, n_in > 0 ? in_sizes[0] : -1, out_size, ws_size); grid = -1; return; }
        int dev = 0, cus = 0, per_cu = 0;
        if (hipGetDevice(&dev) != hipSuccess || hipDeviceGetAttribute(&cus, hipDeviceAttributeMultiprocessorCount, dev) != hipSuccess) { fprintf(stderr, "kernel_launch: device query failed\n"); grid = -1; return; }
        if (hipFuncSetAttribute((const void*)mk_fwd, hipFuncAttributeMaxDynamicSharedMemorySize, LDS_BYTES) != hipSuccess) { fprintf(stderr, "kernel_launch: hipFuncSetAttribute failed\n"); grid = -1; return; }
        if (hipOccupancyMaxActiveBlocksPerMultiprocessor(&per_cu, (const void*)mk_fwd, NWAVES * 64, LDS_BYTES) != hipSuccess || per_cu < 1)
            fprintf(stderr, "kernel_launch: note: occupancy query reports %d workgroups per CU\n", per_cu);
        (void)hipGetLastError();
        grid = cus;
    }
    if (grid < 0) return;
    if (hipMemsetAsync((char*)d_ws + WS_CTL, 0, CTL_ZERO_BYTES, stream) != hipSuccess) { fprintf(stderr, "kernel_launch: memset failed\n"); return; }
    Args a{};
    a.p.x = (const float*)d_in[0]; a.p.c = (const float*)d_in[1]; a.p.pos = (const int*)d_in[2]; a.p.w_ada = (const float*)d_in[3]; a.p.b_ada = (const float*)d_in[4];
    a.p.g1 = (const float*)d_in[5]; a.p.w1in = (const float*)d_in[6]; a.p.w1out = (const float*)d_in[7]; a.p.g2 = (const float*)d_in[8]; a.p.w_in = (const float*)d_in[9];
    a.p.w_pool = (const float*)d_in[10]; a.p.pool_scale = (const float*)d_in[11]; a.p.w_pb = (const float*)d_in[12]; a.p.w_ab = (const float*)d_in[13]; a.p.w_out = (const float*)d_in[14];
    a.p.g3 = (const float*)d_in[15]; a.p.w2in = (const float*)d_in[16]; a.p.w2out = (const float*)d_in[17]; a.p.gf = (const float*)d_in[18];
    a.p.out = (float*)d_out; a.p.ws = (unsigned char*)d_ws;
    const int nl = (N_LAUNCHES == 1) ? ((MK_DOUBLE >= 0) ? 2 : 1) : N_LAUNCHES;
    for (int li = 0; li < nl; ++li) {
        if (N_LAUNCHES == 1) { a.ph_lo = (li == 0) ? 0 : MK_DOUBLE; a.ph_hi = (nl == 2 && li == 0) ? MK_DOUBLE + 1 : NPH; } else { a.ph_lo = li; a.ph_hi = li + 1; }
        a.li = li;
        hipLaunchKernelGGL(mk_fwd, dim3(grid), dim3(NWAVES * 64), LDS_BYTES, stream, a);
        const hipError_t le = hipPeekAtLastError();
        if (le != hipSuccess) { fprintf(stderr, "kernel_launch: launch %d failed: %s\n", li, hipGetErrorName(le)); break; }
    }
}
```

```cpp
#include <hip/hip_runtime.h>
#include <cstdio>
#include <cstdint>
#define MK_N_LAUNCHES 1
namespace pg8 {
#define PG8_LAS __attribute__((address_space(3)))
typedef unsigned short bf16_t;
typedef short bf16x8 __attribute__((ext_vector_type(8)));
typedef float f32x4 __attribute__((ext_vector_type(4)));
typedef unsigned u32x4 __attribute__((ext_vector_type(4)));
constexpr int BM = 256, BK = 64, HALF = 128, HTB = HALF * BK * 2  , STAGE_BYTES = 8 * HTB, NXCD = 8, WGM = 8;

__host__ __device__ __forceinline__ int lds_byte(int r, int c) { const int st = (r >> 4) * 2 + (c >> 5), rr = r & 15, cc = c & 31, ob = rr * 64 + cc * 2; return st * 1024 + (ob ^ (((ob >> 9) & 1) << 5)); }
__host__ __device__ __forceinline__ void stage_rc(int b, int& R, int& C) { const int st = b / 1024, sb = b % 1024, swz = sb ^ (((sb >> 9) & 1) << 5); R = (st >> 1) * 16 + swz / 64; C = (st & 1) * 32 + (swz % 64) / 2; }
__host__ __device__ __forceinline__ int perm32(int rho) { const int n = rho >> 4, i = rho & 15; return 8 * (i >> 2) + 4 * n + (i & 3); }

struct Unit { int pm, pn; };
struct Gemm { const bf16_t* A; const bf16_t* Bt; int M, N, K, ld; };

struct StaticOrder {
    int nM, nN, nwg, G, c;
    __host__ __device__ void init(int M, int N, int G_, int c_) { nM = M / BM; nN = N / BM; nwg = nM * nN; G = G_; c = c_; }
    __host__ __device__ bool next(int i, Unit& u) const {
        const long L = (long)i * G + c; if (L >= nwg) return false;
        int wgid = (int)L; { const int q = nwg / NXCD, r = nwg % NXCD, xcd = wgid % NXCD, off = wgid / NXCD; wgid = (xcd < r ? xcd * (q + 1) : r * (q + 1) + (xcd - r) * q) + off; }
        const int nig = WGM * nN, gid = wgid / nig, fm = gid * WGM, gsz = (nM - fm) < WGM ? (nM - fm) : WGM;
        u.pm = fm + ((wgid % nig) % gsz); u.pn = (wgid % nig) / gsz; return true;
    }
    __device__ __forceinline__ void a_ready(const Unit&) const {}
    __device__ __forceinline__ void done(const Unit&) const {}
};

__device__ __forceinline__ unsigned cvt_pk_bf16(float lo, float hi) { unsigned r; asm volatile("v_cvt_pk_bf16_f32 %0, %1, %2" : "=v"(r) : "v"(lo), "v"(hi)); return r; }
template <class Epi, class Sched, bool ALIGN_EPI = false, bool SP2 = false>
__device__ __forceinline__ void gemm_phase(PG8_LAS unsigned char* lds, const Gemm g, const Sched& S, const Epi& E) {
    const int tid = threadIdx.x, wid = __builtin_amdgcn_readfirstlane(tid >> 6), lane = tid & 63, wr = wid >> 2, wc = wid & 3, fr = lane & 15, fq = lane >> 4;
    const int K = g.K, nt = K / BK, LD = g.ld;
    unsigned voffA[2], voffB[2];
#pragma unroll
    for (int i = 0; i < 2; ++i) { int R, C; stage_rc(tid * 16 + i * 8192, R, C); const int Rb = Epi::PERM ? ((R & ~31) + perm32(R & 31)) : R;
        voffA[i] = (unsigned)(R * LD + C) * 2u; voffB[i] = (unsigned)(Rb * LD + C) * 2u; }
    const size_t kstep = (size_t)(BK * 2);
    const size_t hstep = (size_t)HALF * LD * 2;
    const size_t tstep = 2 * hstep;
    const unsigned ldsw = (unsigned)wid * 1024u;
    const int aoff = lds_byte(wr * 64 + fr, fq * 8), boff = lds_byte(wc * 32 + fr, fq * 8);
#define PG8_SA(b, h) (((b) * 2 + (h)) * HTB)
#define PG8_SB(b, h) ((4 + (b) * 2 + (h)) * HTB)
#define PG8_STAGE(bufoff, gbase, voff) do { _Pragma("unroll") for (int _i = 0; _i < 2; ++_i) \
        __builtin_amdgcn_global_load_lds((const unsigned*)((const char*)(gbase) + (voff)[_i]), (PG8_LAS unsigned*)(lds + (bufoff) + ldsw + _i * 8192), 16, 0, 0); } while (0)
#define PG8_LDA(dst, b, h) do { _Pragma("unroll") for (int m = 0; m < 4; ++m) _Pragma("unroll") for (int k = 0; k < 2; ++k) dst[m][k] = *(const PG8_LAS bf16x8*)(lds + PG8_SA(b, h) + aoff + m * 2048 + k * 1024); } while (0)
#define PG8_LDB(dst, b, h) do { _Pragma("unroll") for (int n = 0; n < 2; ++n) _Pragma("unroll") for (int k = 0; k < 2; ++k) dst[n][k] = *(const PG8_LAS bf16x8*)(lds + PG8_SB(b, h) + boff + n * 2048 + k * 1024); } while (0)
#define PG8_MMA(ai, bj, At, Bt) do { __builtin_amdgcn_s_setprio(1); _Pragma("unroll") for (int m = 0; m < 4; ++m) _Pragma("unroll") for (int n = 0; n < 2; ++n) _Pragma("unroll") for (int k = 0; k < 2; ++k) \
        acc[ai][bj][m][n] = __builtin_amdgcn_mfma_f32_16x16x32_bf16(Bt[n][k], At[m][k], acc[ai][bj][m][n], 0, 0, 0); __builtin_amdgcn_s_setprio(0); } while (0)
#define PG8_WAIT_V(n) asm volatile("s_waitcnt vmcnt(" #n ")" ::: "memory")
#define PG8_WAIT_L(n) asm volatile("s_waitcnt lgkmcnt(" #n ")" ::: "memory")
#define PG8_BAR __builtin_amdgcn_s_barrier()
#define PG8_SCHED __builtin_amdgcn_sched_barrier(0)
    Unit cur, nxt; int ui = 0;
    if (!S.next(0, cur)) return;
    f32x4 acc[2][2][4][2];
#pragma unroll
    for (int a = 0; a < 2; ++a)
#pragma unroll
        for (int b = 0; b < 2; ++b)
#pragma unroll
            for (int m = 0; m < 4; ++m)
#pragma unroll
                for (int n = 0; n < 2; ++n) acc[a][b][m][n] = (f32x4){0.f, 0.f, 0.f, 0.f};
    bf16x8 At[4][2], B0[2][2], B1[2][2];
    const char* cA = (const char*)g.A + (size_t)cur.pm * tstep; const char* cB = (const char*)g.Bt + (size_t)cur.pn * tstep;
    S.a_ready(cur);
    if constexpr (SP2) {
        PG8_STAGE(PG8_SB(0, 0), cB, voffB); PG8_STAGE(PG8_SB(0, 1), cB + hstep, voffB); PG8_STAGE(PG8_SA(0, 0), cA, voffA); PG8_STAGE(PG8_SA(0, 1), cA + hstep, voffA);
        if (wr == 1) PG8_BAR;
        PG8_WAIT_V(2); PG8_BAR;
        PG8_STAGE(PG8_SB(1, 0), cB + kstep, voffB); PG8_STAGE(PG8_SA(1, 0), cA + kstep, voffA); PG8_STAGE(PG8_SB(1, 1), cB + hstep + kstep, voffB);
        PG8_WAIT_V(6); PG8_BAR;
    } else {
        PG8_STAGE(PG8_SB(0, 0), cB, voffB); PG8_STAGE(PG8_SA(0, 0), cA, voffA); PG8_STAGE(PG8_SB(0, 1), cB + hstep, voffB); PG8_STAGE(PG8_SA(0, 1), cA + hstep, voffA);
        if (wr == 1) PG8_BAR;
        PG8_WAIT_V(4); PG8_BAR;
        PG8_STAGE(PG8_SB(1, 0), cB + kstep, voffB); PG8_STAGE(PG8_SA(1, 0), cA + kstep, voffA); PG8_STAGE(PG8_SB(1, 1), cB + hstep + kstep, voffB);
        PG8_WAIT_V(6); PG8_BAR;
    }
    for (;;) {
        const bool has_next = S.next(ui + 1, nxt);
        const char* nA = has_next ? (const char*)g.A + (size_t)nxt.pm * tstep : cA; const char* nB = has_next ? (const char*)g.Bt + (size_t)nxt.pn * tstep : cB;
        for (int t = 0; t < nt; t += 2) {
            const bool last = (t == nt - 2);
            const char* a1 = cA + (size_t)(t + 1) * kstep;
            const char* a2 = last ? nA : cA + (size_t)(t + 2) * kstep; const char* b2 = last ? nB : cB + (size_t)(t + 2) * kstep;
            const char* a3 = a2 + kstep; const char* b3 = b2 + kstep;
            if (last && has_next) S.a_ready(nxt);
            if constexpr (SP2) {
            const bool use0 = !Epi::MERGE || t < nt / 2, use1 = !Epi::MERGE || t >= nt / 2;
            if (use0) PG8_LDB(B0, 0, 0); if (use1) PG8_LDB(B1, 0, 1); PG8_SCHED; PG8_LDA(At, 0, 0); PG8_STAGE(PG8_SA(1, 1), a1 + hstep, voffA);
            PG8_WAIT_V(8); PG8_WAIT_L(0); PG8_BAR; if (use0) PG8_MMA(0, 0, At, B0); if (use1) PG8_MMA(0, 1, At, B1); PG8_BAR; PG8_SCHED;
            PG8_LDA(At, 0, 1); PG8_STAGE(PG8_SB(0, 0), b2, voffB); PG8_STAGE(PG8_SB(0, 1), b2 + hstep, voffB); PG8_STAGE(PG8_SA(0, 0), a2, voffA);
            PG8_WAIT_V(8); PG8_WAIT_L(0); PG8_BAR; if (use0) PG8_MMA(1, 0, At, B0); if (use1) PG8_MMA(1, 1, At, B1); PG8_BAR; PG8_SCHED;
            if (use0) PG8_LDB(B0, 1, 0); if (use1) PG8_LDB(B1, 1, 1); PG8_SCHED; PG8_LDA(At, 1, 0); PG8_STAGE(PG8_SA(0, 1), a2 + hstep, voffA);
            PG8_WAIT_V(8); PG8_WAIT_L(0); PG8_BAR; if (use0) PG8_MMA(0, 0, At, B0); if (use1) PG8_MMA(0, 1, At, B1); PG8_BAR; PG8_SCHED;
            PG8_LDA(At, 1, 1); PG8_STAGE(PG8_SB(1, 0), b3, voffB); PG8_STAGE(PG8_SB(1, 1), b3 + hstep, voffB); PG8_STAGE(PG8_SA(1, 0), a3, voffA);
            PG8_WAIT_V(8); PG8_WAIT_L(0); PG8_BAR; if (use0) PG8_MMA(1, 0, At, B0); if (use1) PG8_MMA(1, 1, At, B1); PG8_BAR; PG8_SCHED;
            } else {
            PG8_LDB(B0, 0, 0); PG8_SCHED; PG8_LDA(At, 0, 0); PG8_STAGE(PG8_SA(1, 1), a1 + hstep, voffA);
            PG8_WAIT_L(8); PG8_BAR; PG8_WAIT_L(0); PG8_MMA(0, 0, At, B0); PG8_BAR; PG8_SCHED;
            PG8_LDB(B1, 0, 1); PG8_STAGE(PG8_SB(0, 0), b2, voffB);
            PG8_BAR; PG8_WAIT_L(0); PG8_MMA(0, 1, At, B1); PG8_BAR;
            PG8_LDA(At, 0, 1); PG8_STAGE(PG8_SA(0, 0), a2, voffA);
            PG8_BAR; PG8_WAIT_L(0); PG8_MMA(1, 0, At, B0); PG8_BAR; PG8_SCHED;
            PG8_STAGE(PG8_SB(0, 1), b2 + hstep, voffB);
            PG8_WAIT_V(6); PG8_BAR; PG8_MMA(1, 1, At, B1); PG8_BAR;
            PG8_LDB(B0, 1, 0); PG8_SCHED; PG8_LDA(At, 1, 0); PG8_STAGE(PG8_SA(0, 1), a2 + hstep, voffA);
            PG8_WAIT_L(8); PG8_BAR; PG8_WAIT_L(0); PG8_MMA(0, 0, At, B0); PG8_BAR; PG8_SCHED;
            PG8_LDB(B1, 1, 1); PG8_STAGE(PG8_SB(1, 0), b3, voffB);
            PG8_BAR; PG8_WAIT_L(0); PG8_MMA(0, 1, At, B1); PG8_BAR;
            PG8_LDA(At, 1, 1); PG8_STAGE(PG8_SA(1, 0), a3, voffA);
            PG8_BAR; PG8_WAIT_L(0); PG8_MMA(1, 0, At, B0); PG8_BAR; PG8_SCHED;
            PG8_STAGE(PG8_SB(1, 1), b3 + hstep, voffB);
            PG8_WAIT_V(6); PG8_BAR; PG8_MMA(1, 1, At, B1); PG8_BAR;
            }
        }
        if constexpr (ALIGN_EPI) { if (wr == 0) PG8_BAR; }
        if constexpr (!Epi::AFTER_DRAIN) { E(acc, cur, wr, wc, fr, fq); S.done(cur); }
        if (!has_next) break;
#pragma unroll
        for (int a = 0; a < 2; ++a)
#pragma unroll
            for (int b = 0; b < 2; ++b)
#pragma unroll
                for (int m = 0; m < 4; ++m)
#pragma unroll
                    for (int n = 0; n < 2; ++n) acc[a][b][m][n] = (f32x4){0.f, 0.f, 0.f, 0.f};
        cur = nxt; cA = nA; cB = nB; ++ui;
        if constexpr (ALIGN_EPI) { if (wr == 1) PG8_BAR; }
    }
    PG8_WAIT_V(0);
    if constexpr (!ALIGN_EPI) { if (wr == 0) PG8_BAR; }
    PG8_BAR;
    if constexpr (Epi::AFTER_DRAIN) { E.fused(acc, cur, wr, wc, fr, fq, lds, wid, lane); S.done(cur); }
#undef PG8_SA
#undef PG8_SB
#undef PG8_STAGE
#undef PG8_LDA
#undef PG8_LDB
#undef PG8_MMA
#undef PG8_WAIT_V
#undef PG8_WAIT_L
#undef PG8_BAR
#undef PG8_SCHED
}
}
namespace mk {
using pg8::f32x4; using pg8::u32x4; using pg8::bf16_t; using pg8::Unit;
typedef float f32x2_t __attribute__((ext_vector_type(2))); typedef __bf16 bf16x2_t __attribute__((ext_vector_type(2)));
__device__ __forceinline__ unsigned cvt_pk_bf16(float lo, float hi) { f32x2_t v = {lo, hi}; bf16x2_t b = __builtin_convertvector(v, bf16x2_t); return __builtin_bit_cast(unsigned, b); }
constexpr int NB = 4, SEQ = 8192, DM = 1024, M = NB * SEQ;
constexpr int DFF = 2816, NFF = 2 * DFF;
constexpr int HLD = 2880;
constexpr int NIN = 4608;
constexpr int NMOD = 9 * DM;
constexpr int QKVW = 768;
constexpr float EPS = 1e-6f;
constexpr float C2 = 0.125f * 1.4426950408889634f;
constexpr int TPB = SEQ / 256;

__device__ __forceinline__ u32x4 pack8(const f32x4 a, const f32x4 b) {
    u32x4 w; w.x = cvt_pk_bf16(a[0], a[1]); w.y = cvt_pk_bf16(a[2], a[3]); w.z = cvt_pk_bf16(b[0], b[1]); w.w = cvt_pk_bf16(b[2], b[3]); return w;
}
__device__ __forceinline__ float bf_lo(unsigned u) { return __uint_as_float(u << 16); }
__device__ __forceinline__ float bf_hi(unsigned u) { return __uint_as_float(u & 0xffff0000u); }
__device__ __forceinline__ float sigmoid_f(float a) { return __builtin_amdgcn_rcpf(1.0f + __builtin_amdgcn_exp2f(-1.4426950408889634f * a)); }
__device__ __forceinline__ f32x4 sigmoid4(const f32x4 a) { f32x4 r; r[0] = sigmoid_f(a[0]); r[1] = sigmoid_f(a[1]); r[2] = sigmoid_f(a[2]); r[3] = sigmoid_f(a[3]); return r; }
__device__ __forceinline__ float row_rstd(const float* ssq, int row, int fq) {
    const f32x4 v = *(const f32x4*)(ssq + (size_t)row * 16 + 4 * fq);
    float s = (v[0] + v[1]) + (v[2] + v[3]);
    s += __shfl_xor(s, 16); s += __shfl_xor(s, 32);
    return __builtin_amdgcn_rsqf(s * (1.0f / (float)DM) + EPS);
}

__device__ __forceinline__ void row_rstd8(const float* ssq, int row0, int fq, float (&rs)[2][4]) {
    f32x4 v[2][4];
#pragma unroll
    for (int ai = 0; ai < 2; ++ai)
#pragma unroll
        for (int m = 0; m < 4; ++m) v[ai][m] = *(const f32x4*)(ssq + (size_t)(row0 + ai * 128 + m * 16) * 16 + 4 * fq);
#pragma unroll
    for (int ai = 0; ai < 2; ++ai)
#pragma unroll
        for (int m = 0; m < 4; ++m) { float t = (v[ai][m][0] + v[ai][m][1]) + (v[ai][m][2] + v[ai][m][3]); t += __shfl_xor(t, 16); t += __shfl_xor(t, 32);
            rs[ai][m] = __builtin_amdgcn_rsqf(t * (1.0f / (float)DM) + EPS); }
}


template <bool NORM> struct EpiSwiglu {
    static constexpr bool PERM = true, AFTER_DRAIN = false, MERGE = false;
    bf16_t* H; const float* ssq; const float* bias;
    __device__ __forceinline__ void operator()(const f32x4 (&acc)[2][2][4][2], const Unit& u, int wr, int wc, int fr, int fq) const {
        const int row0 = u.pm * 256 + wr * 64 + fr, hcol = u.pn * 128 + wc * 32 + 8 * fq;
        f32x4 bv[2][2];
        if (NORM) { const float* bp = bias + (size_t)(u.pm / TPB) * NFF + u.pn * 256 + wc * 32 + 8 * fq;
#pragma unroll
            for (int bj = 0; bj < 2; ++bj)
#pragma unroll
                for (int n = 0; n < 2; ++n) bv[bj][n] = *(const f32x4*)(bp + bj * 128 + 4 * n); }
        float rsv[2][4];
        if (NORM) row_rstd8(ssq, row0, fq, rsv);
#pragma unroll
        for (int ai = 0; ai < 2; ++ai)
#pragma unroll
            for (int m = 0; m < 4; ++m) {
                const int row = row0 + ai * 128 + m * 16;
                f32x4 a0 = acc[ai][0][m][0], a1 = acc[ai][0][m][1], b0 = acc[ai][1][m][0], b1 = acc[ai][1][m][1];
                if (NORM) { const float rs = rsv[ai][m]; a0 = a0 * rs + bv[0][0]; a1 = a1 * rs + bv[0][1]; b0 = b0 * rs + bv[1][0]; b1 = b1 * rs + bv[1][1]; }
                f32x4 e0, e1;
#pragma unroll
                for (int i = 0; i < 4; ++i) { e0[i] = __builtin_amdgcn_rcpf(1.0f + __builtin_amdgcn_exp2f(a0[i])); e1[i] = __builtin_amdgcn_rcpf(1.0f + __builtin_amdgcn_exp2f(a1[i])); }
                const f32x4 h0 = (a0 * b0) * e0, h1 = (a1 * b1) * e1;
                *(u32x4*)(H + (size_t)row * HLD + hcol) = pack8(h0, h1);
            }
    }
};

typedef _Float16 h16x8 __attribute__((ext_vector_type(8)));
typedef float f32x8 __attribute__((ext_vector_type(8)));
template <bool AOUT, bool HALFG, bool IN16, bool SSQ> struct EpiResid {
    static constexpr bool PERM = true, AFTER_DRAIN = false, MERGE = false;
    const void* hin; _Float16* hout; const float* gate; bf16_t* A; const float* g; const float* sc; float* ssq;
    __device__ __forceinline__ void operator()(const f32x4 (&acc)[2][2][4][2], const Unit& u, int wr, int wc, int fr, int fq) const {
        const int b = u.pm / TPB, row0 = u.pm * 256 + wr * 64 + fr, col0 = u.pn * 256 + wc * 32 + 8 * fq;
        f32x4 gt[2][2], gs[2][2];
#pragma unroll
        for (int bj = 0; bj < 2; ++bj)
#pragma unroll
            for (int n = 0; n < 2; ++n) { const int c = col0 + bj * 128 + 4 * n;
                gt[bj][n] = *(const f32x4*)(gate + (size_t)b * NMOD + c) * (HALFG ? 0.5f : 1.0f);
                if (AOUT) gs[bj][n] = *(const f32x4*)(g + c) * (*(const f32x4*)(sc + (size_t)b * NMOD + c) + 1.0f); }
        constexpr int MB = IN16 ? 4 : 1;
#pragma unroll
        for (int rb = 0; rb < 8; rb += MB) {
            f32x4 r0[IN16 ? 1 : MB][2], r1[IN16 ? 1 : MB][2]; h16x8 rh[IN16 ? MB : 1][2];
#pragma unroll
            for (int k = 0; k < MB; ++k) { const int ai = (rb + k) >> 2, m = (rb + k) & 3; const size_t off = (size_t)(row0 + ai * 128 + m * 16) * DM + col0;
#pragma unroll
                for (int bj = 0; bj < 2; ++bj) {
                    if (IN16) rh[IN16 ? k : 0][bj] = *(const h16x8*)((const _Float16*)hin + off + bj * 128);
                    else { r0[IN16 ? 0 : k][bj] = *(const f32x4*)((const float*)hin + off + bj * 128); r1[IN16 ? 0 : k][bj] = *(const f32x4*)((const float*)hin + off + bj * 128 + 4); } } }
#pragma unroll
            for (int k = 0; k < MB; ++k) { const int ai = (rb + k) >> 2, m = (rb + k) & 3;
                const int row = row0 + ai * 128 + m * 16; const size_t off = (size_t)row * DM + col0;
                f32x4 hv[2][2]; float q = 0.f;
#pragma unroll
                for (int bj = 0; bj < 2; ++bj) {
                    f32x4 x0, x1;
                    if (IN16) { const f32x8 rf = __builtin_convertvector(rh[IN16 ? k : 0][bj], f32x8); x0 = (f32x4){rf[0], rf[1], rf[2], rf[3]}; x1 = (f32x4){rf[4], rf[5], rf[6], rf[7]}; }
                    else { x0 = r0[IN16 ? 0 : k][bj]; x1 = r1[IN16 ? 0 : k][bj]; }
                    const f32x4 h0 = x0 + gt[bj][0] * acc[ai][bj][m][0], h1 = x1 + gt[bj][1] * acc[ai][bj][m][1]; hv[bj][0] = h0; hv[bj][1] = h1;
                    const f32x8 hf = {h0[0], h0[1], h0[2], h0[3], h1[0], h1[1], h1[2], h1[3]};
                    *(h16x8*)(hout + off + bj * 128) = __builtin_convertvector(hf, h16x8);
                    if (SSQ) q += ((h0[0] * h0[0] + h0[1] * h0[1]) + (h0[2] * h0[2] + h0[3] * h0[3])) + ((h1[0] * h1[0] + h1[1] * h1[1]) + (h1[2] * h1[2] + h1[3] * h1[3])); }
                if (AOUT) {
#pragma unroll
                    for (int bj = 0; bj < 2; ++bj) *(u32x4*)(A + off + bj * 128) = pack8(hv[bj][0] * gs[bj][0], hv[bj][1] * gs[bj][1]); }
                if (SSQ) { q += __shfl_xor(q, 16); q += __shfl_xor(q, 32);
                    if (fq == 0) ssq[(size_t)row * 16 + 4 * u.pn + wc] = q; }
            }
            asm volatile("" ::: "memory");
        }
    }
};

struct EpiInProj {
    static constexpr bool PERM = true, AFTER_DRAIN = false, MERGE = false;
    const float* ssq; const float* bias; const float* cs; float* PP; bf16_t* Q; bf16_t* K; bf16_t* V; bf16_t* G;
    __device__ __forceinline__ void operator()(const f32x4 (&acc)[2][2][4][2], const Unit& u, int wr, int wc, int fr, int fq) const {
        const int row0 = u.pm * 256 + wr * 64 + fr, pn = u.pn;
        f32x4 bv[2][2];
        { const float* bp = bias + (size_t)(u.pm / TPB) * NIN + pn * 256 + wc * 32 + 8 * fq;
#pragma unroll
            for (int bj = 0; bj < 2; ++bj)
#pragma unroll
                for (int n = 0; n < 2; ++n) bv[bj][n] = *(const f32x4*)(bp + bj * 128 + 4 * n); }
        float rsv[2][4];
        row_rstd8(ssq, row0, fq, rsv);
        if (pn == 0) {
#pragma unroll
            for (int ai = 0; ai < 2; ++ai)
#pragma unroll
                for (int m = 0; m < 4; ++m) { const int row = row0 + ai * 128 + m * 16; const float rs = rsv[ai][m];
                    float* dst = PP + (size_t)row * 256 + wc * 32 + 8 * fq;
#pragma unroll
                    for (int bj = 0; bj < 2; ++bj)
#pragma unroll
                        for (int n = 0; n < 2; ++n) *(f32x4*)(dst + bj * 128 + 4 * n) = acc[ai][bj][m][n] * rs + bv[bj][n]; }
        } else if (pn <= 6) {
            const bool isq = pn <= 3; const int head = 4 * (isq ? pn - 1 : pn - 4) + wc; const float osc = isq ? C2 : 1.0f;
            bf16_t* base = (isq ? Q : K) + head * 64 + 8 * fq;
#pragma unroll
            for (int rb = 0; rb < 8; rb += 2) {
                f32x4 cc[2][2], ss[2][2];
#pragma unroll
                for (int k = 0; k < 2; ++k) { const int ai = (rb + k) >> 2, m = (rb + k) & 3; const float* cp = cs + (size_t)(row0 + ai * 128 + m * 16) * 64 + 8 * fq;
#pragma unroll
                    for (int n = 0; n < 2; ++n) { cc[k][n] = *(const f32x4*)(cp + 4 * n); ss[k][n] = *(const f32x4*)(cp + 32 + 4 * n); } }
#pragma unroll
                for (int k = 0; k < 2; ++k) { const int ai = (rb + k) >> 2, m = (rb + k) & 3; const int row = row0 + ai * 128 + m * 16; const float rs = rsv[ai][m];
                    f32x4 o1[2], o2[2];
#pragma unroll
                    for (int n = 0; n < 2; ++n) { const f32x4 c = cc[k][n] * osc, sn = ss[k][n] * osc;
                        const f32x4 x1 = acc[ai][0][m][n] * rs + bv[0][n], x2 = acc[ai][1][m][n] * rs + bv[1][n];
                        o1[n] = x1 * c - x2 * sn; o2[n] = x2 * c + x1 * sn; }
                    bf16_t* dst = base + (size_t)row * QKVW;
                    *(u32x4*)dst = pack8(o1[0], o1[1]); *(u32x4*)(dst + 32) = pack8(o2[0], o2[1]); }
                asm volatile("" ::: "memory"); }
        } else if (pn <= 9) {
            bf16_t* base = V + (pn - 7) * 256 + wc * 32 + 8 * fq;
#pragma unroll
            for (int ai = 0; ai < 2; ++ai)
#pragma unroll
                for (int m = 0; m < 4; ++m) { const int row = row0 + ai * 128 + m * 16; const float rs = rsv[ai][m];
                    bf16_t* dst = base + (size_t)row * QKVW;
#pragma unroll
                    for (int bj = 0; bj < 2; ++bj) *(u32x4*)(dst + bj * 128) = pack8(acc[ai][bj][m][0] * rs + bv[bj][0], acc[ai][bj][m][1] * rs + bv[bj][1]); }
        } else {
            bf16_t* base = G + (pn - 10) * 256 + wc * 32 + 8 * fq;
#pragma unroll
            for (int ai = 0; ai < 2; ++ai)
#pragma unroll
                for (int m = 0; m < 4; ++m) { const int row = row0 + ai * 128 + m * 16; const float rs = rsv[ai][m];
                    bf16_t* dst = base + (size_t)row * 2048;
#pragma unroll
                    for (int bj = 0; bj < 2; ++bj) *(u32x4*)(dst + bj * 128) = pack8(sigmoid4(acc[ai][bj][m][0] * rs + bv[bj][0]), sigmoid4(acc[ai][bj][m][1] * rs + bv[bj][1])); }
        }
    }
};

struct EpiMerge {
    static constexpr bool PERM = true, AFTER_DRAIN = false, MERGE = true;
    const bf16_t* G; bf16_t* Y;
    __device__ __forceinline__ void operator()(const f32x4 (&acc)[2][2][4][2], const Unit& u, int wr, int wc, int fr, int fq) const {
        const int row0 = u.pm * 256 + wr * 64 + fr, c = u.pn * 128 + wc * 32 + 8 * fq;
#pragma unroll
        for (int ai = 0; ai < 2; ++ai) {
            u32x4 gp[4], ga[4];
#pragma unroll
            for (int m = 0; m < 4; ++m) { const size_t r = (size_t)(row0 + ai * 128 + m * 16) * 2048 + c; gp[m] = *(const u32x4*)(G + r); ga[m] = *(const u32x4*)(G + r + 1024); }
#pragma unroll
            for (int m = 0; m < 4; ++m) { const int row = row0 + ai * 128 + m * 16; const u32x4 p = gp[m], a = ga[m];
                const f32x4 p0 = {bf_lo(p.x), bf_hi(p.x), bf_lo(p.y), bf_hi(p.y)}, p1 = {bf_lo(p.z), bf_hi(p.z), bf_lo(p.w), bf_hi(p.w)};
                const f32x4 a0 = {bf_lo(a.x), bf_hi(a.x), bf_lo(a.y), bf_hi(a.y)}, a1 = {bf_lo(a.z), bf_hi(a.z), bf_lo(a.w), bf_hi(a.w)};
                const f32x4 y0 = p0 * acc[ai][0][m][0] + a0 * acc[ai][1][m][0], y1 = p1 * acc[ai][0][m][1] + a1 * acc[ai][1][m][1];
                *(u32x4*)(Y + (size_t)row * DM + c) = pack8(y0, y1); }
            asm volatile("" ::: "memory"); }
    }
};
struct EpiNull {
    static constexpr bool PERM = true, AFTER_DRAIN = false, MERGE = false;
    float* sink;
    __device__ __forceinline__ void operator()(const f32x4 (&acc)[2][2][4][2], const Unit& u, int wr, int wc, int fr, int fq) const {
        f32x4 t = {0.f, 0.f, 0.f, 0.f};
#pragma unroll
        for (int ai = 0; ai < 2; ++ai)
#pragma unroll
            for (int bj = 0; bj < 2; ++bj)
#pragma unroll
                for (int m = 0; m < 4; ++m)
#pragma unroll
                    for (int n = 0; n < 2; ++n) t += acc[ai][bj][m][n];
        const float v = (t[0] + t[1]) + (t[2] + t[3]);
        if (v == 123456.789f) sink[u.pm] = v;
    }
};
}

namespace at {
typedef short bf16x8 __attribute__((ext_vector_type(8)));
typedef float f32x16 __attribute__((ext_vector_type(16)));
typedef short v4i16_t __attribute__((ext_vector_type(4)));
typedef __attribute__((address_space(3))) unsigned char* lds_ptr;
constexpr int SEQ = 8192, PITCH = 768;
constexpr float NEG = -INFINITY;

__device__ __forceinline__ unsigned cvt2(float lo, float hi) { typedef float f2 __attribute__((ext_vector_type(2))); typedef __bf16 b2 __attribute__((ext_vector_type(2))); f2 v = {lo, hi}; b2 b = __builtin_convertvector(v, b2); return __builtin_bit_cast(unsigned, b); }

__device__ __forceinline__ void dma_v(const unsigned short* Vh, long rowbase, int dsh, int i0, int kt, lds_ptr slot, int lane) {
#pragma unroll
    for (int u = 0; u < 4; ++u) { int idx = i0 - 128 + 32 * kt + 8 * u + (lane >> 3); idx = idx < 0 ? 0 : idx;
        const unsigned short* src = Vh + (rowbase + ((long)idx << dsh)) * PITCH + 8 * (lane & 7);
        __builtin_amdgcn_global_load_lds((const unsigned*)src, (__attribute__((address_space(3))) unsigned*)(slot + u * 1024), 16, 0, 0); }
}

struct Frags { bf16x8 q[4]; bf16x8 k[5][4]; };
__device__ __forceinline__ void load_frags(Frags& f, const unsigned short* Qh, const unsigned short* Kh, long rowbase, int dsh, int i0, int lane) {
    const int q = lane & 31, hh = lane >> 5;
    const unsigned short* qp = Qh + (rowbase + ((long)(i0 + q) << dsh)) * PITCH + 8 * hh;
#pragma unroll
    for (int s = 0; s < 4; ++s) f.q[s] = *(const bf16x8*)(qp + 16 * s);
#pragma unroll
    for (int kt = 0; kt < 5; ++kt) { int idx = i0 - 128 + 32 * kt + q; idx = idx < 0 ? 0 : idx;
        const unsigned short* kp = Kh + (rowbase + ((long)idx << dsh)) * PITCH + 8 * hh;
#pragma unroll
        for (int s = 0; s < 4; ++s) f.k[kt][s] = *(const bf16x8*)(kp + 16 * s); }
}
struct TaskP { const unsigned short* Qh; const unsigned short* Kh; const unsigned short* Vh; unsigned short* OGh; float* LSj; long rowbase; int dsh, i0; };

template <class ParamFn> __device__ __forceinline__ void run_tasks(const ParamFn& param, int ntask, lds_ptr vlds, int lane) {
    const int q = lane & 31, hh = lane >> 5;
    const int g4 = lane >> 4, li = lane & 15;
    const int trbase = (4 * (g4 >> 1) + (li >> 2)) * 128 + (16 * (g4 & 1) + 4 * (li & 3)) * 2;
    TaskP tp = param(0);
    Frags fr; load_frags(fr, tp.Qh, tp.Kh, tp.rowbase, tp.dsh, tp.i0, lane);
    for (int n = 0; n < ntask; ++n) {
        const int i0 = tp.i0, dsh = tp.dsh; const long rowbase = tp.rowbase;
        const int ninv = i0 < 128 ? (128 - i0) >> 5 : 0;
        dma_v(tp.Vh, rowbase, dsh, i0, 0, vlds, lane); dma_v(tp.Vh, rowbase, dsh, i0, 1, vlds + 4096, lane); dma_v(tp.Vh, rowbase, dsh, i0, 2, vlds + 8192, lane); dma_v(tp.Vh, rowbase, dsh, i0, 3, vlds + 12288, lane);
        __builtin_amdgcn_sched_barrier(0);
        f32x16 S[5];
#pragma unroll
        for (int kt = 0; kt < 5; ++kt) { f32x16 acc = {};
#pragma unroll
            for (int s = 0; s < 4; ++s) acc = __builtin_amdgcn_mfma_f32_32x32x16_bf16(fr.k[kt][s], fr.q[s], acc, 0, 0, 0);
            S[kt] = acc; }
        float mx = NEG;
#pragma unroll
        for (int kt = 0; kt < 5; ++kt) {
#pragma unroll
            for (int i = 0; i < 16; ++i) { const int kr = (i & 3) + 8 * (i >> 2) + 4 * hh; bool ok = kt >= ninv;
                if (kt == 0) ok = ok && (kr >= q);
                if (kt == 4) ok = ok && (kr <= q);
                const float v = ok ? S[kt][i] : NEG; S[kt][i] = v; mx = fmaxf(mx, v); } }
        mx = fmaxf(mx, __shfl_xor(mx, 32));
        float l = 0.f;
        union PF { bf16x8 v; unsigned u[4]; } pf[5][2];
#pragma unroll
        for (int kt = 0; kt < 5; ++kt)
#pragma unroll
            for (int s2 = 0; s2 < 2; ++s2)
#pragma unroll
                for (int e = 0; e < 4; ++e) { const float p0 = __builtin_amdgcn_exp2f(S[kt][8 * s2 + 2 * e] - mx), p1 = __builtin_amdgcn_exp2f(S[kt][8 * s2 + 2 * e + 1] - mx); l += p0 + p1; pf[kt][s2].u[e] = cvt2(p0, p1); }
        l += __shfl_xor(l, 32);
        const long qrow = rowbase + ((long)(i0 + q) << dsh);
        unsigned short* const orow = tp.OGh + qrow * 256; float* const lsp = tp.LSj + qrow * 4;
        const unsigned short* const Vh = tp.Vh;
        asm volatile("s_waitcnt vmcnt(0)" ::: "memory");
        __builtin_amdgcn_sched_barrier(0);
        if (n + 1 < ntask) { tp = param(n + 1); load_frags(fr, tp.Qh, tp.Kh, tp.rowbase, tp.dsh, tp.i0, lane); }
        __builtin_amdgcn_sched_barrier(0);
        f32x16 O0 = {}, O1 = {};
#define AT_PV(kt, slot) do { _Pragma("unroll") for (int s2 = 0; s2 < 2; ++s2) { \
        _Pragma("unroll") for (int db = 0; db < 2; ++db) { \
            const lds_ptr p0 = vlds + (slot) * 4096 + trbase + s2 * 16 * 128 + db * 64; \
            const v4i16_t lo = __builtin_amdgcn_ds_read_tr16_b64_v4i16((__attribute__((address_space(3))) v4i16_t*)p0); \
            const v4i16_t hi = __builtin_amdgcn_ds_read_tr16_b64_v4i16((__attribute__((address_space(3))) v4i16_t*)(p0 + 8 * 128)); \
            const bf16x8 vf = {lo[0], lo[1], lo[2], lo[3], hi[0], hi[1], hi[2], hi[3]}; \
            if (db == 0) O0 = __builtin_amdgcn_mfma_f32_32x32x16_bf16(vf, pf[kt][s2].v, O0, 0, 0, 0); else O1 = __builtin_amdgcn_mfma_f32_32x32x16_bf16(vf, pf[kt][s2].v, O1, 0, 0, 0); } } } while (0)
        AT_PV(0, 0);
        asm volatile("s_waitcnt lgkmcnt(0)" ::: "memory");
        __builtin_amdgcn_sched_barrier(0);
        dma_v(Vh, rowbase, dsh, i0, 4, vlds, lane);
        __builtin_amdgcn_sched_barrier(0);
        AT_PV(1, 1); AT_PV(2, 2); AT_PV(3, 3);
        asm volatile("s_waitcnt vmcnt(0)" ::: "memory");
        __builtin_amdgcn_sched_barrier(0);
        AT_PV(4, 0);
#undef AT_PV
        asm volatile("s_waitcnt lgkmcnt(0)" ::: "memory");
        __builtin_amdgcn_sched_barrier(0);
        const float rl = 1.0f / l;
#pragma unroll
        for (int db = 0; db < 2; ++db)
#pragma unroll
            for (int gq = 0; gq < 4; ++gq) { const f32x16& O = db == 0 ? O0 : O1;
                const unsigned long long w = (unsigned long long)cvt2(O[4 * gq] * rl, O[4 * gq + 1] * rl) | ((unsigned long long)cvt2(O[4 * gq + 2] * rl, O[4 * gq + 3] * rl) << 32);
                *(unsigned long long*)(orow + 32 * db + 8 * gq + 4 * hh) = w; }
        if (hh == 0) lsp[0] = mx + __log2f(l);
    }
}
}
constexpr int NWAVES = 8;
#ifdef MK_TIMING
constexpr int NPH = 12;
#else
constexpr int NPH = 11;
#endif
#ifndef MK_SP2
#define MK_SP2 true
#endif
#ifndef MK_DOUBLE
#define MK_DOUBLE -1
#endif
#ifndef MK_N_LAUNCHES
#define MK_N_LAUNCHES 1
#endif
constexpr int N_LAUNCHES = MK_N_LAUNCHES;
static_assert(N_LAUNCHES == 1 || N_LAUNCHES == NPH, "MK_N_LAUNCHES is 1 or NPH");

using mk::NB; using mk::SEQ; using mk::DM; using mk::M; using mk::DFF; using mk::NFF; using mk::NIN; using mk::NMOD; using mk::QKVW;

constexpr size_t MiB = 1u << 20;
constexpr size_t WS_CTL = 0, CTL_ZERO_BYTES = 1 * MiB;
constexpr size_t WS_MOD = 1 * MiB;
constexpr size_t WS_BIAS2 = 1 * MiB + 256 * 1024;
constexpr size_t WS_BIAS3 = 1 * MiB + 512 * 1024;
constexpr size_t WS_SSQ2 = 2 * MiB, WS_SSQ3 = 4 * MiB, WS_SSQF = 6 * MiB;
constexpr size_t WS_CS = 8 * MiB;
constexpr size_t WS_W1IN = 16 * MiB, WS_W1OUT = 27 * MiB, WS_WIN = 33 * MiB, WS_WM = 42 * MiB, WS_WOUT = 44 * MiB, WS_W2IN = 46 * MiB, WS_W2OUT = 57 * MiB;
constexpr size_t WS_XA = 64 * MiB;
constexpr size_t WS_YA = 128 * MiB;
constexpr size_t WS_PP = 160 * MiB;
constexpr size_t WS_Q = 192 * MiB, WS_K = 240 * MiB, WS_V = 288 * MiB;
constexpr size_t WS_G = 336 * MiB;
constexpr size_t WS_MERGED = 192 * MiB;
constexpr size_t WS_HID = 192 * MiB;
constexpr size_t WS_END = 464 * MiB;
static_assert(WS_W1IN + (size_t)NFF * DM * 2 <= WS_W1OUT && WS_W1OUT + (size_t)DM * mk::HLD * 2 <= WS_WIN && WS_WIN + (size_t)NIN * DM * 2 <= WS_WM && WS_WM + (size_t)2048 * 512 * 2 <= WS_WOUT &&
              WS_WOUT + (size_t)DM * DM * 2 <= WS_W2IN && WS_W2IN + (size_t)NFF * DM * 2 <= WS_W2OUT && WS_W2OUT + (size_t)DM * mk::HLD * 2 <= WS_XA, "weight map");
static_assert(WS_HID + (size_t)M * mk::HLD * 2 <= WS_END && WS_G + (size_t)M * 2048 * 2 <= WS_END && WS_MERGED + (size_t)M * DM * 2 <= WS_V, "activation map");
constexpr int CW_BAR = 4096;

constexpr int RING_OFF = 0, RING_BYTES = 131072;
constexpr int LDSCTL_OFF = RING_BYTES, MISC_OFF = LDSCTL_OFF + 320;
constexpr int LDS_BYTES = 147456;
static_assert(MISC_OFF + 128 <= LDS_BYTES, "LDS map");

#define GAS __attribute__((address_space(1)))
#define LAS __attribute__((address_space(3)))
typedef unsigned short bf16;
typedef unsigned v4u __attribute__((ext_vector_type(4)));
typedef float f32x4 __attribute__((ext_vector_type(4)));
typedef short bf16x8 __attribute__((ext_vector_type(8)));
typedef GAS unsigned gu32;
typedef GAS unsigned long long gu64;
#define RLX_AGENT __ATOMIC_RELAXED, __HIP_MEMORY_SCOPE_AGENT
#define LDS_WAIT() asm volatile("s_waitcnt lgkmcnt(0)" ::: "memory")
#define VM_WAIT() asm volatile("s_waitcnt vmcnt(0)" ::: "memory")
__device__ __forceinline__ unsigned long long rt() { return __builtin_amdgcn_s_memrealtime(); }
__device__ __forceinline__ unsigned f2bf(float f) { unsigned u = __builtin_bit_cast(unsigned, f); return (u + 0x7fffu + ((u >> 16) & 1u)) >> 16; }
__device__ __forceinline__ unsigned pk2(float lo, float hi) { return f2bf(lo) | (f2bf(hi) << 16); }

#define XB_TMO      128
#define XB_XCNT(j)  (256  + 64 * (j))
#define XB_XSUB(j)  (1280 + 64 * (j))
#define XB_XGEN(j)  (2304 + 64 * (j))
#define XB_TOP      3328
#define XB_TOPGEN   3392
#define XCD_BAR_WORDS 3456
#define XB_SPIN_CAP (1u << 18)

__device__ __forceinline__ unsigned xb_ld(unsigned* p)              { return __hip_atomic_load(p, __ATOMIC_RELAXED, __HIP_MEMORY_SCOPE_AGENT); }
__device__ __forceinline__ unsigned xb_add(unsigned* p, unsigned v) { return __hip_atomic_fetch_add(p, v, __ATOMIC_RELAXED, __HIP_MEMORY_SCOPE_AGENT); }
__device__ __forceinline__ unsigned xb_xcc_id() { return (unsigned)__builtin_amdgcn_s_getreg((3 << 11) | 20) & 0xFu; }
#define XB_SPIN(cond, bar) do { unsigned _sp = 0; while (cond) { __builtin_amdgcn_s_sleep(1); \
    if ((++_sp & 255u) == 0u) { if (xb_ld(&(bar)[XB_TMO])) break; if (_sp > XB_SPIN_CAP) { atomicAdd(&(bar)[XB_TMO], 1u); break; } } } } while (0)

struct XcdBarrier {
    unsigned* bar; unsigned x;
    volatile LAS unsigned* st;
};

__device__ __forceinline__ XcdBarrier xcd_barrier_post(unsigned* bar, volatile LAS unsigned* st) {
    XcdBarrier b; b.bar = bar; b.x = xb_xcc_id(); b.st = st;
    if (threadIdx.x == 0) (void)xb_add(&bar[XB_XCNT(b.x)], 1u);
    return b;
}
__device__ __forceinline__ void xcd_barrier_complete(unsigned* bar, unsigned x, unsigned& nloc, unsigned& nx) {
    const unsigned G = gridDim.x * gridDim.y * gridDim.z;
    unsigned sum, cnt, mine, sp = 0u;
    for (;;) {
        sum = 0u; cnt = 0u; mine = 0u;
#pragma unroll
        for (unsigned j = 0; j < 16; ++j) { const unsigned c = xb_ld(&bar[XB_XCNT(j)]); sum += c; cnt += (c > 0u) ? 1u : 0u; mine = (j == x) ? c : mine; }
        if (sum == G) break;
        __builtin_amdgcn_s_sleep(1);
        if ((++sp & 255u) == 0u) { if (xb_ld(&bar[XB_TMO])) break; if (sp > XB_SPIN_CAP) { atomicAdd(&bar[XB_TMO], 1u); break; } }
    }
    nloc = mine > 0u ? mine : 1u; nx = cnt > 0u ? cnt : 1u;
}

__device__ __forceinline__ void xcd_barrier(const XcdBarrier& b) {
    asm volatile("s_waitcnt vmcnt(0)" ::: "memory");
    __syncthreads();
    if (threadIdx.x == 0) {
        unsigned* bar = b.bar;
        __builtin_amdgcn_s_waitcnt(0);
        unsigned nloc = b.st[0], nx = b.st[1];
        if (nloc == 0u) { xcd_barrier_complete(bar, b.x, nloc, nx); b.st[0] = nloc; b.st[1] = nx; }
        const unsigned old = xb_add(&bar[XB_XSUB(b.x)], 1u);
        const unsigned gen = old / nloc;
        if (old + 1u == (gen + 1u) * nloc) {
            __builtin_amdgcn_fence(__ATOMIC_RELEASE, "agent");
            asm volatile("s_waitcnt vmcnt(0)" ::: "memory");
            const unsigned og = xb_add(&bar[XB_TOP], 1u);
            const unsigned tg = og / nx;
            if (og + 1u == (tg + 1u) * nx) xb_add(&bar[XB_TOPGEN], 1u);
            else XB_SPIN(xb_ld(&bar[XB_TOPGEN]) == tg, bar);
            __builtin_amdgcn_fence(__ATOMIC_ACQUIRE, "agent");
            xb_add(&bar[XB_XGEN(b.x)], 1u);
            asm volatile("s_waitcnt vmcnt(0)" ::: "memory");
        } else {
            XB_SPIN(xb_ld(&bar[XB_XGEN(b.x)]) == gen, bar);
            __builtin_amdgcn_fence(__ATOMIC_ACQUIRE, "agent");
            asm volatile("s_waitcnt vmcnt(0)" ::: "memory");
        }
    }
    __syncthreads();
}

struct Frame {
    LAS unsigned char* lds;
    volatile LAS unsigned* MISC;
    gu32* ctl;
    int tid, lane, wave;
    int vcu, G;
};
__device__ __forceinline__ float wave_sum(float v) {
#pragma unroll
    for (int o = 1; o < 64; o <<= 1) v += __shfl_xor(v, o);
    return v;
}
__device__ __forceinline__ float wave_max(float v) {
#pragma unroll
    for (int o = 1; o < 64; o <<= 1) v = fmaxf(v, __shfl_xor(v, o));
    return v;
}
__device__ __forceinline__ float silu_f(float a) { return a * mk::sigmoid_f(a); }

__device__ __forceinline__ void tr_item(const float* W, int N, int k0, int n0, bf16* WT, int Kd, int dst_row0, int dst_k0, LAS float* scr, int lane, float scale = 1.0f) {
#pragma unroll 8
    for (int i = 0; i < 32; ++i) { const int kk = 2 * i + (lane >> 5); scr[kk * 33 + (lane & 31)] = W[(size_t)(k0 + kk) * N + n0 + (lane & 31)] * scale; }
    LDS_WAIT(); asm volatile("" ::: "memory");
    const int c = lane & 7;
#pragma unroll
    for (int j = 0; j < 4; ++j) { const int n = (lane >> 3) + 8 * j; const LAS float* s = scr + (8 * c) * 33 + n;
        v4u o; o.x = pk2(s[0 * 33], s[1 * 33]); o.y = pk2(s[2 * 33], s[3 * 33]); o.z = pk2(s[4 * 33], s[5 * 33]); o.w = pk2(s[6 * 33], s[7 * 33]);
        *(v4u*)(WT + (size_t)(dst_row0 + n) * Kd + dst_k0 + 8 * c) = o; }
    LDS_WAIT(); asm volatile("" ::: "memory");
}
__device__ __forceinline__ void zero_item(bf16* WT, int Kd, int dst_row0, int dst_k0, int lane) {
    const int c = lane & 7;
#pragma unroll
    for (int j = 0; j < 4; ++j) { const int n = (lane >> 3) + 8 * j; *(v4u*)(WT + (size_t)(dst_row0 + n) * Kd + dst_k0 + 8 * c) = (v4u){0u, 0u, 0u, 0u}; }
}
__device__ __forceinline__ int ffn_row0(int n0) { const int half = n0 >= DFF ? 1 : 0, j = n0 - half * DFF; return 256 * (j >> 7) + 128 * half + (j & 127); }
__device__ __forceinline__ int inproj_row0(int n0) {
    if (n0 < 1024) { const int e = n0 - 256, head = e >> 6, bj = (e >> 5) & 1; return 256 * (1 + (head >> 2)) + 128 * bj + 32 * (head & 3); }
    if (n0 < 1792) { const int e = n0 - 1024, head = e >> 6, bj = (e >> 5) & 1; return 256 * (4 + (head >> 2)) + 128 * bj + 32 * (head & 3); }
    return n0;
}

struct Ptrs {
    const float *x, *c; const int* pos; const float *w_ada, *b_ada, *g1, *w1in, *w1out, *g2, *w_in, *w_pool, *pool_scale, *w_pb, *w_ab, *w_out, *g3, *w2in, *w2out, *gf;
    float* out; unsigned char* ws;
};

__constant__ float INV_FREQ[32] = {
    1.0f, 0.74989420933f, 0.56234132519f, 0.42169650343f, 0.31622776602f, 0.23713737057f, 0.17782794100f, 0.13335214322f,
    0.1f, 0.074989420933f, 0.056234132519f, 0.042169650343f, 0.031622776602f, 0.023713737057f, 0.017782794100f, 0.013335214322f,
    0.01f, 0.0074989420933f, 0.0056234132519f, 0.0042169650343f, 0.0031622776602f, 0.0023713737057f, 0.0017782794100f, 0.0013335214322f,
    0.001f, 0.00074989420933f, 0.00056234132519f, 0.00042169650343f, 0.00031622776602f, 0.00023713737057f, 0.00017782794100f, 0.00013335214322f };

__device__ __forceinline__ void p0_prologue(Frame& F, const Ptrs& P) {
    unsigned char* ws = P.ws;
    float* mod = (float*)(ws + WS_MOD);
    {
        LAS float* cond = (LAS float*)(F.lds + RING_OFF);
        LAS float* red = (LAS float*)(F.lds + RING_OFF + 16384);
        for (int i = F.tid; i < NB * DM; i += NWAVES * 64) { const int b = i >> 10, k = i & 1023; cond[k * 4 + b] = silu_f(P.c[i]); }
        __syncthreads();
        for (int item = F.vcu; item < NMOD / 64; item += F.G) {
            const int n = item * 64 + F.lane; float a0 = 0.f, a1 = 0.f, a2 = 0.f, a3 = 0.f;
            const float* wp = P.w_ada + (size_t)(F.wave * 128) * NMOD + n;
#pragma unroll 8
            for (int k = 0; k < 128; ++k) { const float w = wp[(size_t)k * NMOD]; const LAS float* cp = cond + (F.wave * 128 + k) * 4; a0 += cp[0] * w; a1 += cp[1] * w; a2 += cp[2] * w; a3 += cp[3] * w; }
            red[(F.wave * 4 + 0) * 64 + F.lane] = a0; red[(F.wave * 4 + 1) * 64 + F.lane] = a1; red[(F.wave * 4 + 2) * 64 + F.lane] = a2; red[(F.wave * 4 + 3) * 64 + F.lane] = a3;
            __syncthreads();
            if (F.wave < 4) { float s = P.b_ada[n];
#pragma unroll
                for (int w = 0; w < 8; ++w) s += red[(w * 4 + F.wave) * 64 + F.lane];
                mod[(size_t)F.wave * NMOD + n] = s; }
            __syncthreads();
        }
    }
    LAS float* scr = (LAS float*)(F.lds + RING_OFF + F.wave * 16384);
    const int gw = F.vcu * NWAVES + F.wave, NGW = F.G * NWAVES;
    constexpr int I_FIN = (DM / 64) * (NFF / 32);
    constexpr int I_FOUT = (DFF / 64) * (DM / 32);
    constexpr int I_IN = (DM / 64) * ((NIN - 256) / 32);
    constexpr int I_BR = (256 / 64) * (DM / 32);
    constexpr int I_OUT = (DM / 64) * (DM / 32);
    constexpr int I_POOL = (DM / 64) * (256 / 32);
    constexpr int I_CS = M / 64;
    constexpr int NITEMS = 2 * I_FIN + 2 * I_FOUT + I_IN + 2 * I_BR + I_OUT + I_POOL + I_CS;
    bf16* W1IN = (bf16*)(ws + WS_W1IN); bf16* W1OUT = (bf16*)(ws + WS_W1OUT); bf16* WIN = (bf16*)(ws + WS_WIN); bf16* WM = (bf16*)(ws + WS_WM);
    bf16* WOUT = (bf16*)(ws + WS_WOUT); bf16* W2IN = (bf16*)(ws + WS_W2IN); bf16* W2OUT = (bf16*)(ws + WS_W2OUT);
    for (int it = gw; it < NITEMS; it += NGW) {
        int r = it;
        if (r < 2 * I_FIN) { const bool second = r >= I_FIN; if (second) r -= I_FIN; const int nblk = NFF / 32, kb = r / nblk, nb = r % nblk;
            tr_item(second ? P.w2in : P.w1in, NFF, 64 * kb, 32 * nb, second ? W2IN : W1IN, DM, ffn_row0(32 * nb), 64 * kb, scr, F.lane, (32 * nb < DFF) ? -1.4426950408889634f : -0.6931471805599453f); continue; }
        r -= 2 * I_FIN;
        if (r < 2 * I_FOUT) { const bool second = r >= I_FOUT; if (second) r -= I_FOUT; const int nblk = DM / 32, kb = r / nblk, nb = r % nblk;
            tr_item(second ? P.w2out : P.w1out, DM, 64 * kb, 32 * nb, second ? W2OUT : W1OUT, mk::HLD, 32 * nb, 64 * kb, scr, F.lane); continue; }
        r -= 2 * I_FOUT;
        if (r < I_IN) { const int nblk = (NIN - 256) / 32, kb = r / nblk, nb = r % nblk, n0 = 256 + 32 * nb;
            tr_item(P.w_in, NIN, 64 * kb, n0, WIN, DM, inproj_row0(n0), 64 * kb, scr, F.lane); continue; }
        r -= I_IN;
        if (r < 2 * I_BR) { const bool attn = r >= I_BR; if (attn) r -= I_BR; const int nblk = DM / 32, kb = r / nblk, nb = r % nblk, n0 = 32 * nb;
            const int row0 = 256 * (n0 >> 7) + (attn ? 128 : 0) + (n0 & 127);
            tr_item(attn ? P.w_ab : P.w_pb, DM, 64 * kb, n0, WM, 512, row0, (attn ? 256 : 0) + 64 * kb, scr, F.lane);
            zero_item(WM, 512, row0, (attn ? 0 : 256) + 64 * kb, F.lane); continue; }
        r -= 2 * I_BR;
        if (r < I_OUT) { const int nblk = DM / 32, kb = r / nblk, nb = r % nblk;
            tr_item(P.w_out, DM, 64 * kb, 32 * nb, WOUT, DM, 32 * nb, 64 * kb, scr, F.lane); continue; }
        r -= I_OUT;
        if (r < I_POOL) {
            const int kb = r / 8, nb = r % 8, g = nb >> 1, dd0 = (nb & 1) * 32, k = 64 * kb + F.lane;
            const float* wr = P.w_in + (size_t)k * NIN + 64 * g; const float* wp = P.w_pool + (size_t)g * 4096 + dd0;
            float o[32];
#pragma unroll
            for (int d = 0; d < 32; ++d) o[d] = 0.f;
            for (int c4 = 0; c4 < 16; ++c4) { const f32x4 a = *(const f32x4*)(wr + 4 * c4);
#pragma unroll
                for (int ci = 0; ci < 4; ++ci) { const float av = a[ci]; const float* wq = wp + (size_t)(4 * c4 + ci) * 64;
#pragma unroll
                    for (int d = 0; d < 32; ++d) o[d] += av * wq[d]; } }
#pragma unroll
            for (int d = 0; d < 32; ++d) { const int np = 32 * nb + d; WIN[(size_t)np * DM + k] = (bf16)f2bf(o[d] * P.pool_scale[np]); }
            continue; }
        r -= I_POOL;
        {
            const int f = F.lane & 31; const float invf = INV_FREQ[f];
            float* cs = (float*)(ws + WS_CS);
            for (int i = 0; i < 32; ++i) { const int m = 64 * r + 2 * i + (F.lane >> 5);
                const float ang = (float)P.pos[m] * invf;
                const double a = (double)ang; const double kq = rint(a * 0.15915494309189535); const double red = fma(-kq, 6.283185307179586, a) - kq * 2.4492935982947064e-16;
                const float rr = (float)red;
                cs[(size_t)m * 64 + f] = cosf(rr); cs[(size_t)m * 64 + 32 + f] = sinf(rr); }
        }
    }
}

__device__ __forceinline__ void p1_prologue(Frame& F, const Ptrs& P) {
    unsigned char* ws = P.ws; const float* mod = (const float*)(ws + WS_MOD);
    const int gw = F.vcu * NWAVES + F.wave, NGW = F.G * NWAVES;
    bf16* XA = (bf16*)(ws + WS_XA);
    for (int m = gw; m < M; m += NGW) {
        const int b = m / SEQ; const f32x4* xr = (const f32x4*)(P.x + (size_t)m * DM) + F.lane;
        f32x4 v[4]; float s = 0.f;
#pragma unroll
        for (int j = 0; j < 4; ++j) { v[j] = xr[64 * j]; s += (v[j].x * v[j].x + v[j].y * v[j].y) + (v[j].z * v[j].z + v[j].w * v[j].w); }
        const float rstd = __builtin_amdgcn_rsqf(wave_sum(s) * (1.f / DM) + mk::EPS);
        unsigned long long* o8 = (unsigned long long*)(XA + (size_t)m * DM) + F.lane;
#pragma unroll
        for (int j = 0; j < 4; ++j) { const int c = 4 * F.lane + 256 * j;
            const f32x4 g = *(const f32x4*)(P.g1 + c), sh = *(const f32x4*)(mod + (size_t)b * NMOD + c), sc = *(const f32x4*)(mod + (size_t)b * NMOD + DM + c);
            const f32x4 y = (v[j] * rstd * g) * (sc + 1.0f) + sh;
            o8[64 * j] = (unsigned long long)pk2(y.x, y.y) | ((unsigned long long)pk2(y.z, y.w) << 32); }
    }
    for (int it = gw; it < NIN + NFF; it += NGW) {
        const bool second = it >= NIN; const int n = second ? it - NIN : it;
        const bf16* wrow = (const bf16*)(ws + (second ? WS_W2IN : WS_WIN)) + (size_t)n * DM + 16 * F.lane;
        const v4u w0 = *(const v4u*)wrow, w1 = *(const v4u*)(wrow + 8);
        float wv[16] = { mk::bf_lo(w0.x), mk::bf_hi(w0.x), mk::bf_lo(w0.y), mk::bf_hi(w0.y), mk::bf_lo(w0.z), mk::bf_hi(w0.z), mk::bf_lo(w0.w), mk::bf_hi(w0.w),
                         mk::bf_lo(w1.x), mk::bf_hi(w1.x), mk::bf_lo(w1.y), mk::bf_hi(w1.y), mk::bf_lo(w1.z), mk::bf_hi(w1.z), mk::bf_lo(w1.w), mk::bf_hi(w1.w) };
        float* dst = (float*)(ws + (second ? WS_BIAS3 : WS_BIAS2));
        const int shoff = (second ? 6 : 3) * DM;
#pragma unroll
        for (int b = 0; b < NB; ++b) { const float* sh = mod + (size_t)b * NMOD + shoff + 16 * F.lane; float s = 0.f;
#pragma unroll
            for (int q = 0; q < 4; ++q) { const f32x4 t = *(const f32x4*)(sh + 4 * q); s += (t.x * wv[4 * q] + t.y * wv[4 * q + 1]) + (t.z * wv[4 * q + 2] + t.w * wv[4 * q + 3]); }
            s = wave_sum(s);
            if (F.lane == 0) dst[(size_t)b * (second ? NFF : NIN) + n] = s; }
    }
}

constexpr size_t WS_OG = WS_XA;
constexpr size_t WS_LS = WS_SSQ3;
static_assert(3 * (size_t)M * 256 * 2 <= 64 * MiB && 3 * (size_t)M * 4 * 4 <= 2 * MiB, "attention scratch fits its hosts");
__device__ __forceinline__ void p5_mixers(Frame& F, const Ptrs& P) {
    unsigned char* ws = P.ws;
    const float* PP = (const float*)(ws + WS_PP); bf16* YA = (bf16*)(ws + WS_YA);
    const bf16* Q = (const bf16*)(ws + WS_Q); const bf16* K = (const bf16*)(ws + WS_K); const bf16* V = (const bf16*)(ws + WS_V);
    bf16* OG = (bf16*)(ws + WS_OG); float* LS = (float*)(ws + WS_LS);
    const int gw = F.vcu * NWAVES + F.wave, NGW = F.G * NWAVES;
    for (int u = F.vcu; u < 256; u += F.G) {
        const int b = u >> 6, j = (u >> 4) & 3, beta = u & 15;
        {
            const int wv = F.wave;
            auto param = [=](int n) { const int tau = wv + NWAVES * n; const int g = tau >> 4, x = tau & 15, h = 4 * g + j;
                const int r = g == 0 ? 0 : (g == 1 ? (x >> 2) : x);
                const int i0 = g == 0 ? 512 * beta + 32 * x : (g == 1 ? 128 * beta + 32 * (x & 3) : 32 * beta);
                at::TaskP t; t.Qh = Q + h * 64; t.Kh = K + h * 64; t.Vh = V + h * 64; t.OGh = OG + (size_t)g * M * 256 + j * 64; t.LSj = LS + (size_t)g * M * 4 + j;
                t.rowbase = (long)b * SEQ + r; t.dsh = 2 * g; t.i0 = i0; return t; };
#ifdef MK_ATT_REP
            for (int rep_ = 0; rep_ < MK_ATT_REP; ++rep_)
#endif
            at::run_tasks(param, 6, (at::lds_ptr)(F.lds + RING_OFF + wv * 16384), F.lane);
        }
        asm volatile("s_waitcnt vmcnt(0)" ::: "memory");
        __syncthreads();
        __builtin_amdgcn_fence(__ATOMIC_ACQUIRE, "agent");
        asm volatile("s_waitcnt vmcnt(0)" ::: "memory");
        for (int it = 0; it < 8; ++it) {
            const size_t row = (size_t)b * SEQ + 512 * beta + 64 * it + (F.tid >> 3); const int ch = F.tid & 7;
            float ls[3]; v4u ov[3];
#pragma unroll
            for (int g = 0; g < 3; ++g) { ls[g] = LS[((size_t)g * M + row) * 4 + j]; ov[g] = *(const v4u*)(OG + ((size_t)g * M + row) * 256 + j * 64 + 8 * ch); }
            const float mx = fmaxf(fmaxf(ls[0], ls[1]), ls[2]);
            const float e0 = __builtin_amdgcn_exp2f(ls[0] - mx), e1 = __builtin_amdgcn_exp2f(ls[1] - mx), e2 = __builtin_amdgcn_exp2f(ls[2] - mx), rs = 1.0f / (e0 + e1 + e2);
            const float w0 = e0 * rs, w1 = e1 * rs, w2 = e2 * rs;
            v4u o;
#define JOIN(c) { const float lo = w0 * mk::bf_lo(ov[0].c) + w1 * mk::bf_lo(ov[1].c) + w2 * mk::bf_lo(ov[2].c), hi = w0 * mk::bf_hi(ov[0].c) + w1 * mk::bf_hi(ov[1].c) + w2 * mk::bf_hi(ov[2].c); o.c = pk2(lo, hi); }
            JOIN(x) JOIN(y) JOIN(z) JOIN(w)
#undef JOIN
            *(v4u*)(YA + row * 512 + 256 + j * 64 + 8 * ch) = o;
        }
        __syncthreads();
    }
    for (int c = gw; c < M / 16; c += NGW) {
        const int R0 = 16 * c, t0 = R0 % SEQ, grp = F.lane >> 4, w = 2 << grp;
        const float* p = PP + (size_t)R0 * 256 + 4 * F.lane;
        f32x4 cs[32];
        cs[0] = (f32x4){0.f, 0.f, 0.f, 0.f};
        f32x4 rows[16];
        const bool hist = t0 != 0;
#pragma unroll
        for (int i = 1; i < 32; ++i) { f32x4 v = (i < 16) ? (hist ? *(const f32x4*)(p + (ptrdiff_t)(i - 16) * 256) : (f32x4){0.f, 0.f, 0.f, 0.f}) : *(const f32x4*)(p + (size_t)(i - 16) * 256);
            if (i >= 16) rows[i - 16] = v; cs[i] = cs[i - 1] + v; }
#pragma unroll
        for (int k = 0; k < 16; ++k) { const int t = t0 + k, cnt = (t + 1 < w) ? t + 1 : w;
            const f32x4 lo = grp == 0 ? cs[16 + k - 2] : (grp == 1 ? cs[16 + k - 4] : (grp == 2 ? cs[16 + k - 8] : cs[16 + k - 16]));
            const f32x4 y = (cs[16 + k] - lo) * (1.0f / (float)cnt) - rows[k];
            *(unsigned long long*)(YA + (size_t)(R0 + k) * 512 + 4 * F.lane) = (unsigned long long)pk2(y.x, y.y) | ((unsigned long long)pk2(y.z, y.w) << 32); }
    }
}

__device__ __forceinline__ void p10_final_norm(Frame& F, const Ptrs& P) {
    const int gw = F.vcu * NWAVES + F.wave, NGW = F.G * NWAVES;
    const _Float16* H3 = (const _Float16*)(P.ws + WS_XA);
    for (int m = gw; m < M; m += NGW) {
        mk::f32x8 v[2]; float s = 0.f;
#pragma unroll
        for (int j = 0; j < 2; ++j) { v[j] = __builtin_convertvector(*(const mk::h16x8*)(H3 + (size_t)m * DM + 8 * F.lane + 512 * j), mk::f32x8);
#pragma unroll
            for (int e = 0; e < 8; ++e) s += v[j][e] * v[j][e]; }
        const float rstd = __builtin_amdgcn_rsqf(wave_sum(s) * (1.f / DM) + mk::EPS);
#pragma unroll
        for (int j = 0; j < 2; ++j) { const int c = 8 * F.lane + 512 * j; const f32x4 g0 = *(const f32x4*)(P.gf + c), g1 = *(const f32x4*)(P.gf + c + 4);
            *(f32x4*)(P.out + (size_t)m * DM + c) = (f32x4){v[j][0], v[j][1], v[j][2], v[j][3]} * rstd * g0;
            *(f32x4*)(P.out + (size_t)m * DM + c + 4) = (f32x4){v[j][4], v[j][5], v[j][6], v[j][7]} * rstd * g1; }
    }
}

struct Args { Ptrs p; int ph_lo, ph_hi, li, pad; };
__global__ void __launch_bounds__(NWAVES * 64, 2) mk_fwd(Args args) {
    extern __shared__ __attribute__((aligned(16))) unsigned char lds[];
    Frame F;
    F.lds = (LAS unsigned char*)lds;
    F.MISC = (volatile LAS unsigned*)(F.lds + MISC_OFF);
    F.tid = threadIdx.x; F.lane = F.tid & 63; F.wave = __builtin_amdgcn_readfirstlane(F.tid >> 6);
    F.G = gridDim.x; { const int bx = blockIdx.x; F.vcu = (F.G % 8 == 0) ? (bx % 8) * (F.G / 8) + bx / 8 : bx; }
    const Ptrs& P = args.p;
    unsigned char* ws = P.ws;
    F.ctl = (gu32*)(ws + WS_CTL);
    for (int u = F.tid; u < (LDS_BYTES - LDSCTL_OFF) / 4; u += NWAVES * 64) ((LAS unsigned*)(F.lds + LDSCTL_OFF))[u] = 0u;
    __syncthreads();
    XcdBarrier bar = xcd_barrier_post((unsigned*)(F.ctl + CW_BAR) + args.li * XCD_BAR_WORDS, F.MISC + 8);
#ifdef MK_TIMING
    constexpr int CW_TS = 65536; int n_stamp = 0;
    if (blockIdx.x == 0 && F.tid == 0) __hip_atomic_store((unsigned long long*)(F.ctl + CW_TS), rt(), RLX_AGENT);
#define GRID_BAR() do { xcd_barrier(bar); ++n_stamp; if (blockIdx.x == 0 && F.tid == 0) __hip_atomic_store((unsigned long long*)(F.ctl + CW_TS) + n_stamp, rt(), RLX_AGENT); } while (0)
#else
#ifdef MK_BAR2
#define GRID_BAR() do { xcd_barrier(bar); xcd_barrier(bar); } while (0)
#else
#define GRID_BAR() xcd_barrier(bar)
#endif
#endif
    const int lo = args.ph_lo, hi = args.ph_hi;
#define IN(k) (lo <= (k) && (k) < hi)
#define BOTH(k) (IN(k) && IN((k) + 1))
    float* mod = (float*)(ws + WS_MOD);
    bf16* XA = (bf16*)(ws + WS_XA); bf16* HID = (bf16*)(ws + WS_HID);
    float* SSQ2 = (float*)(ws + WS_SSQ2); float* SSQ3 = (float*)(ws + WS_SSQ3);
    _Float16* H16 = (_Float16*)P.out;

    if (IN(0)) { p0_prologue(F, P); if (BOTH(0)) GRID_BAR(); }
    if (IN(1)) { p1_prologue(F, P); if (BOTH(1)) GRID_BAR(); }
    if (IN(2)) {
        pg8::Gemm g{XA, (const bf16*)(ws + WS_W1IN), M, NFF, DM, DM}; pg8::StaticOrder S; S.init(M, NFF, F.G, (int)blockIdx.x);
        mk::EpiSwiglu<false> E{HID, nullptr, nullptr};
        pg8::gemm_phase<mk::EpiSwiglu<false>, pg8::StaticOrder, true, MK_SP2>(F.lds + RING_OFF, g, S, E);
        if (BOTH(2)) GRID_BAR();
    }
#ifdef MK_NULLEPI
    if (IN(2)) {
        GRID_BAR();
        pg8::Gemm g{XA, (const bf16*)(ws + WS_W1IN), M, NFF, DM, DM}; pg8::StaticOrder S; S.init(M, NFF, F.G, (int)blockIdx.x);
        mk::EpiNull E{(float*)(ws + WS_SSQF)};
        pg8::gemm_phase<mk::EpiNull, pg8::StaticOrder, true, MK_SP2>(F.lds + RING_OFF, g, S, E);
        GRID_BAR();
    }
#endif
    if (IN(3)) {
        pg8::Gemm g{HID, (const bf16*)(ws + WS_W1OUT), M, DM, DFF, mk::HLD}; pg8::StaticOrder S; S.init(M, DM, F.G, (int)blockIdx.x);
        mk::EpiResid<true, true, false, true> E{P.x, H16, mod + 2 * DM, XA, P.g2, mod + 4 * DM, SSQ2};
        pg8::gemm_phase<mk::EpiResid<true, true, false, true>, pg8::StaticOrder, true, MK_SP2>(F.lds + RING_OFF, g, S, E);
        if (BOTH(3)) GRID_BAR();
    }
    if (IN(4)) {
        pg8::Gemm g{XA, (const bf16*)(ws + WS_WIN), M, NIN, DM, DM}; pg8::StaticOrder S; S.init(M, NIN, F.G, (int)blockIdx.x);
        mk::EpiInProj E{SSQ2, (const float*)(ws + WS_BIAS2), (const float*)(ws + WS_CS), (float*)(ws + WS_PP), (bf16*)(ws + WS_Q), (bf16*)(ws + WS_K), (bf16*)(ws + WS_V), (bf16*)(ws + WS_G)};
        pg8::gemm_phase<mk::EpiInProj, pg8::StaticOrder, true, MK_SP2>(F.lds + RING_OFF, g, S, E);
        if (BOTH(4)) GRID_BAR();
    }
    if (IN(5)) { p5_mixers(F, P); if (BOTH(5)) GRID_BAR(); }
    if (IN(6)) {
        pg8::Gemm g{(const bf16*)(ws + WS_YA), (const bf16*)(ws + WS_WM), M, 2048, 512, 512}; pg8::StaticOrder S; S.init(M, 2048, F.G, (int)blockIdx.x);
        mk::EpiMerge E{(const bf16*)(ws + WS_G), (bf16*)(ws + WS_MERGED)};
        pg8::gemm_phase<mk::EpiMerge, pg8::StaticOrder, true, MK_SP2>(F.lds + RING_OFF, g, S, E);
        if (BOTH(6)) GRID_BAR();
    }
    if (IN(7)) {
        pg8::Gemm g{(const bf16*)(ws + WS_MERGED), (const bf16*)(ws + WS_WOUT), M, DM, DM, DM}; pg8::StaticOrder S; S.init(M, DM, F.G, (int)blockIdx.x);
        mk::EpiResid<true, false, true, true> E{H16, H16, mod + 5 * DM, XA, P.g3, mod + 7 * DM, SSQ3};
        pg8::gemm_phase<mk::EpiResid<true, false, true, true>, pg8::StaticOrder, true, MK_SP2>(F.lds + RING_OFF, g, S, E);
        if (BOTH(7)) GRID_BAR();
    }
    if (IN(8)) {
        pg8::Gemm g{XA, (const bf16*)(ws + WS_W2IN), M, NFF, DM, DM}; pg8::StaticOrder S; S.init(M, NFF, F.G, (int)blockIdx.x);
        mk::EpiSwiglu<true> E{HID, SSQ3, (const float*)(ws + WS_BIAS3)};
        pg8::gemm_phase<mk::EpiSwiglu<true>, pg8::StaticOrder, true, MK_SP2>(F.lds + RING_OFF, g, S, E);
        if (BOTH(8)) GRID_BAR();
    }
    if (IN(9)) {
        pg8::Gemm g{HID, (const bf16*)(ws + WS_W2OUT), M, DM, DFF, mk::HLD}; pg8::StaticOrder S; S.init(M, DM, F.G, (int)blockIdx.x);
        mk::EpiResid<false, true, true, false> E{H16, (_Float16*)XA, mod + 8 * DM, nullptr, nullptr, nullptr, nullptr};
        pg8::gemm_phase<mk::EpiResid<false, true, true, false>, pg8::StaticOrder, true, MK_SP2>(F.lds + RING_OFF, g, S, E);
        if (BOTH(9)) GRID_BAR();
    }
    if (IN(10)) { p10_final_norm(F, P); if (BOTH(10)) GRID_BAR(); }
#ifdef MK_TIMING
    if (IN(11)) {
        const unsigned long long* ts = (const unsigned long long*)(F.ctl + CW_TS);
        const unsigned long long a0 = __hip_atomic_load(ts + MK_TIMING, RLX_AGENT), a1 = __hip_atomic_load(ts + MK_TIMING + 1, RLX_AGENT), a2 = __hip_atomic_load(ts + MK_TIMING + 2, RLX_AGENT);
        const float ta = (float)(a1 - a0) * 0.01f, tb = (float)(a2 - a1) * 0.01f;
        for (size_t i = (size_t)blockIdx.x * 512 + F.tid; i < 8388608; i += (size_t)F.G * 512) P.out[1048576 + i] = 10.0f * tb;
        if (blockIdx.x == 0 && F.tid == 0) P.out[0] = 1e3f * ta;
    }
#endif
#undef IN
#undef BOTH
#undef GRID_BAR
}

extern "C" void kernel_launch(void* const* d_in, const int* in_sizes, int n_in, void* d_out, int out_size, void* d_ws, size_t ws_size, hipStream_t stream) {
    static int grid = 0;
    if (grid == 0) {
        if (n_in != 19 || in_sizes[0] != M * DM || out_size != M * DM || ws_size < WS_END) { fprintf(stderr, "kernel_launch: unexpected shapes (n_in %d, in0 %d, out %d, ws %zu); nothing launched\n", n_in, n_in > 0 ? in_sizes[0] : -1, out_size, ws_size); grid = -1; return; }
        int dev = 0, cus = 0, per_cu = 0;
        if (hipGetDevice(&dev) != hipSuccess || hipDeviceGetAttribute(&cus, hipDeviceAttributeMultiprocessorCount, dev) != hipSuccess) { fprintf(stderr, "kernel_launch: device query failed\n"); grid = -1; return; }
        if (hipFuncSetAttribute((const void*)mk_fwd, hipFuncAttributeMaxDynamicSharedMemorySize, LDS_BYTES) != hipSuccess) { fprintf(stderr, "kernel_launch: hipFuncSetAttribute failed\n"); grid = -1; return; }
        if (hipOccupancyMaxActiveBlocksPerMultiprocessor(&per_cu, (const void*)mk_fwd, NWAVES * 64, LDS_BYTES) != hipSuccess || per_cu < 1)
            fprintf(stderr, "kernel_launch: note: occupancy query reports %d workgroups per CU\n", per_cu);
        (void)hipGetLastError();
        grid = cus;
    }
    if (grid < 0) return;
    if (hipMemsetAsync((char*)d_ws + WS_CTL, 0, CTL_ZERO_BYTES, stream) != hipSuccess) { fprintf(stderr, "kernel_launch: memset failed\n"); return; }
    Args a{};
    a.p.x = (const float*)d_in[0]; a.p.c = (const float*)d_in[1]; a.p.pos = (const int*)d_in[2]; a.p.w_ada = (const float*)d_in[3]; a.p.b_ada = (const float*)d_in[4];
    a.p.g1 = (const float*)d_in[5]; a.p.w1in = (const float*)d_in[6]; a.p.w1out = (const float*)d_in[7]; a.p.g2 = (const float*)d_in[8]; a.p.w_in = (const float*)d_in[9];
    a.p.w_pool = (const float*)d_in[10]; a.p.pool_scale = (const float*)d_in[11]; a.p.w_pb = (const float*)d_in[12]; a.p.w_ab = (const float*)d_in[13]; a.p.w_out = (const float*)d_in[14];
    a.p.g3 = (const float*)d_in[15]; a.p.w2in = (const float*)d_in[16]; a.p.w2out = (const float*)d_in[17]; a.p.gf = (const float*)d_in[18];
    a.p.out = (float*)d_out; a.p.ws = (unsigned char*)d_ws;
    const int nl = (N_LAUNCHES == 1) ? ((MK_DOUBLE >= 0) ? 2 : 1) : N_LAUNCHES;
    for (int li = 0; li < nl; ++li) {
        if (N_LAUNCHES == 1) { a.ph_lo = (li == 0) ? 0 : MK_DOUBLE; a.ph_hi = (nl == 2 && li == 0) ? MK_DOUBLE + 1 : NPH; } else { a.ph_lo = li; a.ph_hi = li + 1; }
        a.li = li;
        hipLaunchKernelGGL(mk_fwd, dim3(grid), dim3(NWAVES * 64), LDS_BYTES, stream, a);
        const hipError_t le = hipPeekAtLastError();
        if (le != hipSuccess) { fprintf(stderr, "kernel_launch: launch %d failed: %s\n", li, hipGetErrorName(le)); break; }
    }
}
```
